# Optimizing an MI355X kernel written in HIP

```python
import jax, jax.numpy as jnp
from jax import lax
import numpy as np

D_MODEL = 1024
BATCH = 8
SEQ = 2048
DEPTH = 4

N_MIXERS = 2
MOBA_HEADS = 16
MOBA_HEAD_DIM = D_MODEL // MOBA_HEADS
MOBA_BLOCK = 256
MOBA_TOPK = 3
MOBA_QCHUNK = 128
GMLP_EXPAND = 6
GMLP_DV = GMLP_EXPAND * D_MODEL // 2
GMLP_GROUPS = 8
GMLP_GROUP_DIM = GMLP_DV // GMLP_GROUPS
GMLP_CHUNK = 128
MOE_GROUPS = 8
MOE_EXPERTS_PER_GROUP = 8
MOE_EXPERTS = MOE_GROUPS * MOE_EXPERTS_PER_GROUP
MOE_TOPK = 2
MOE_D_EXPERT = D_MODEL // 4
MOE_ROW_BLOCK = 128
LN_EPS = 1e-5
DEEPNORM_ALPHA = (2.0 * DEPTH) ** 0.25
DEEPNORM_BETA = (8.0 * DEPTH) ** -0.25
N_MOBA_LAYERS = (DEPTH + 1) // 2
N_GMLP_LAYERS = DEPTH // 2

kernel_name = "hybrid_moba_gmlp_hmoe_deepnorm"


def layer_norm(x, g, b):
    xf = x.astype(jnp.float32)
    mu = jnp.mean(xf, axis=-1, keepdims=True)
    var = jnp.mean(jnp.square(xf - mu), axis=-1, keepdims=True)
    y = (xf - mu) * lax.rsqrt(var + LN_EPS)
    return (y * g + b).astype(x.dtype)


def moba_attention(x, w_qkv, w_o):
    B, S, D = x.shape
    H, DH, KB, QC = MOBA_HEADS, MOBA_HEAD_DIM, MOBA_BLOCK, MOBA_QCHUNK
    nb = -(-S // KB)
    nq = S // QC
    k_sel = min(MOBA_TOPK, nb)
    scale = DH ** -0.5

    qkv = (x @ w_qkv).reshape(B, S, 3, H, DH)
    q = qkv[:, :, 0].transpose(0, 2, 1, 3)
    k = qkv[:, :, 1].transpose(0, 2, 1, 3)
    v = qkv[:, :, 2].transpose(0, 2, 1, 3)
    pad = nb * KB - S
    k_blocks = jnp.pad(k, ((0, 0), (0, 0), (0, pad), (0, 0))).reshape(B, H, nb, KB, DH)
    v_blocks = jnp.pad(v, ((0, 0), (0, 0), (0, pad), (0, 0))).reshape(B, H, nb, KB, DH)
    k_mean = jnp.mean(k_blocks.astype(jnp.float32), axis=3)

    q_chunks = q.reshape(B, H, nq, QC, DH).transpose(0, 2, 1, 3, 4).reshape(B * nq, H, QC, DH)
    b_ids = jnp.repeat(jnp.arange(B), nq)
    n_ids = jnp.tile(jnp.arange(nq), B)
    head_ids = jnp.arange(H)[:, None, None]

    def step(args):
        qc, b, n = args
        kb, vb, km = k_blocks[b], v_blocks[b], k_mean[b]
        cur = (n * QC) // KB
        blk_scores = jnp.einsum('hqd,hjd->hqj', qc.astype(jnp.float32), km)
        past = jnp.arange(nb) < cur
        blk_scores = jnp.where(past[None, None, :], blk_scores, -jnp.inf)
        _, sel = lax.top_k(blk_scores, k_sel)
        sel_valid = sel < cur
        kg = kb[head_ids, sel]
        vg = vb[head_ids, sel]
        s_sel = jnp.einsum('hqd,hqjkd->hqjk', qc, kg,
                           preferred_element_type=jnp.float32) * scale
        s_sel = jnp.where(sel_valid[..., None], s_sel, -jnp.inf).reshape(H, QC, k_sel * KB)
        k_own = lax.dynamic_slice_in_dim(kb, cur, 1, axis=1)[:, 0]
        v_own = lax.dynamic_slice_in_dim(vb, cur, 1, axis=1)[:, 0]
        s_own = jnp.einsum('hqd,hkd->hqk', qc, k_own,
                           preferred_element_type=jnp.float32) * scale
        q_pos = n * QC + jnp.arange(QC)
        k_pos = cur * KB + jnp.arange(KB)
        s_own = jnp.where((k_pos[None, :] <= q_pos[:, None])[None], s_own, -jnp.inf)
        p = jax.nn.softmax(jnp.concatenate([s_sel, s_own], axis=-1), axis=-1)
        p_sel = p[..., :k_sel * KB].reshape(H, QC, k_sel, KB).astype(vg.dtype)
        p_own = p[..., k_sel * KB:].astype(v_own.dtype)
        out = (jnp.einsum('hqjk,hqjkd->hqd', p_sel, vg)
               + jnp.einsum('hqk,hkd->hqd', p_own, v_own))
        return out.astype(x.dtype)

    o = lax.map(step, (q_chunks, b_ids, n_ids))
    o = o.reshape(B, nq, H, QC, DH).transpose(0, 1, 3, 2, 4).reshape(B, S, D)
    return o @ w_o


def chunked_gmlp(x, w_in, b_in, ln_v_g, ln_v_b, w_s, b_s, w_out):
    B, S, _ = x.shape
    z = jax.nn.gelu(x @ w_in + b_in, approximate=False)
    u, v = jnp.split(z, 2, axis=-1)
    v = layer_norm(v, ln_v_g, ln_v_b)
    v = v.reshape(B, S // GMLP_CHUNK, GMLP_CHUNK, GMLP_GROUPS, GMLP_GROUP_DIM)
    w_causal = jnp.tril(w_s)
    mixed = jnp.einsum('gts,bcsgk->bctgk', w_causal, v) + b_s.T[:, :, None]
    return (u * mixed.reshape(B, S, GMLP_DV)) @ w_out


def grouped_expert_ffn(xf, expert_id, gates, w1, w3, w2):
    T, D = xf.shape
    E, R = MOE_EXPERTS, MOE_ROW_BLOCK
    A = expert_id.size
    n_blk = -(-A // R) + E
    flat_e = expert_id.reshape(-1)
    order = jnp.argsort(flat_e)
    sorted_e = flat_e[order]
    tok = order // expert_id.shape[1]
    counts = jnp.bincount(flat_e, length=E)
    start = jnp.cumsum(counts) - counts
    padded = ((counts + R - 1) // R) * R
    pad_end = jnp.cumsum(padded)
    pad_start = pad_end - padded
    dest = pad_start[sorted_e] + (jnp.arange(A) - start[sorted_e])
    buf = jnp.zeros((n_blk * R, D), xf.dtype).at[dest].set(xf[tok])
    blk_expert = jnp.clip(jnp.searchsorted(pad_end, jnp.arange(n_blk) * R, side='right'), 0, E - 1)

    def run_block(args):
        rows, e = args
        h = jax.nn.silu(rows @ w1[e]) * (rows @ w3[e])
        return h @ w2[e]

    y_buf = lax.map(run_block, (buf.reshape(n_blk, R, D), blk_expert)).reshape(n_blk * R, D)
    g_sorted = gates.reshape(-1)[order].astype(xf.dtype)
    return jax.ops.segment_sum(y_buf[dest] * g_sorted[:, None], tok, num_segments=T)


def hier_moe(x, w_grp, b_grp, w_rt, b_rt, w1, w3, w2):
    B, S, D = x.shape
    T = B * S
    xf = x.reshape(T, D)
    g_prob = jax.nn.softmax((xf @ w_grp + b_grp).astype(jnp.float32), axis=-1)
    g_p, g_idx = lax.top_k(g_prob, 1)
    e_logits = (xf @ w_rt + b_rt).astype(jnp.float32).reshape(T, MOE_GROUPS, MOE_EXPERTS_PER_GROUP)
    e_logits = jnp.take_along_axis(e_logits, g_idx[:, :, None], axis=1)[:, 0]
    e_top, e_local = lax.top_k(e_logits, MOE_TOPK)
    gates = g_p * jax.nn.softmax(e_top, axis=-1)
    expert_id = g_idx * MOE_EXPERTS_PER_GROUP + e_local
    return grouped_expert_ffn(xf, expert_id, gates, w1, w3, w2).reshape(B, S, D)


def setup_inputs(seed: int = 0) -> dict:
    key = jax.random.key(seed)
    ks = jax.random.split(key, 24)
    D, E, F = D_MODEL, MOE_EXPERTS, MOE_D_EXPERT
    nrm = lambda k, shape, s: jax.random.normal(k, shape, jnp.float32) * s
    return {
        "x": nrm(ks[0], (BATCH, SEQ, D), 1.0),
        "moba_w_qkv": nrm(ks[1], (N_MOBA_LAYERS, D, 3 * D), D ** -0.5),
        "moba_w_o": nrm(ks[2], (N_MOBA_LAYERS, D, D), D ** -0.5 * DEEPNORM_BETA),
        "gmlp_w_in": nrm(ks[3], (N_GMLP_LAYERS, D, 2 * GMLP_DV), D ** -0.5),
        "gmlp_b_in": nrm(ks[4], (N_GMLP_LAYERS, 2 * GMLP_DV), 0.02),
        "gmlp_ln_g": 1.0 + nrm(ks[5], (N_GMLP_LAYERS, GMLP_DV), 0.02),
        "gmlp_ln_b": nrm(ks[6], (N_GMLP_LAYERS, GMLP_DV), 0.02),
        "gmlp_w_s": nrm(ks[7], (N_GMLP_LAYERS, GMLP_GROUPS, GMLP_CHUNK, GMLP_CHUNK), GMLP_CHUNK ** -0.5),
        "gmlp_b_s": 1.0 + nrm(ks[8], (N_GMLP_LAYERS, GMLP_GROUPS, GMLP_CHUNK), 0.02),
        "gmlp_w_out": nrm(ks[9], (N_GMLP_LAYERS, GMLP_DV, D), GMLP_DV ** -0.5 * DEEPNORM_BETA),
        "ln1_g": 1.0 + nrm(ks[10], (DEPTH, D), 0.02),
        "ln1_b": nrm(ks[11], (DEPTH, D), 0.02),
        "ln2_g": 1.0 + nrm(ks[12], (DEPTH, D), 0.02),
        "ln2_b": nrm(ks[13], (DEPTH, D), 0.02),
        "moe_w_grp": nrm(ks[14], (DEPTH, D, MOE_GROUPS), D ** -0.5),
        "moe_b_grp": nrm(ks[15], (DEPTH, MOE_GROUPS), 0.01),
        "moe_w_rt": nrm(ks[16], (DEPTH, D, E), D ** -0.5),
        "moe_b_rt": nrm(ks[17], (DEPTH, E), 0.01),
        "moe_w1": nrm(ks[18], (DEPTH, E, D, F), D ** -0.5),
        "moe_w3": nrm(ks[19], (DEPTH, E, D, F), D ** -0.5),
        "moe_w2": nrm(ks[20], (DEPTH, E, F, D), F ** -0.5 * DEEPNORM_BETA),
    }


def reference(x, moba_w_qkv, moba_w_o, gmlp_w_in, gmlp_b_in, gmlp_ln_g, gmlp_ln_b, gmlp_w_s,
              gmlp_b_s, gmlp_w_out, ln1_g, ln1_b, ln2_g, ln2_b, moe_w_grp, moe_b_grp, moe_w_rt,
              moe_b_rt, moe_w1, moe_w3, moe_w2):
    for i in range(DEPTH):
        j = i // N_MIXERS
        if i % N_MIXERS == 0:
            h = moba_attention(x, moba_w_qkv[j], moba_w_o[j])
        else:
            h = chunked_gmlp(x, gmlp_w_in[j], gmlp_b_in[j], gmlp_ln_g[j], gmlp_ln_b[j],
                             gmlp_w_s[j], gmlp_b_s[j], gmlp_w_out[j])
        x = layer_norm(DEEPNORM_ALPHA * x + h, ln1_g[i], ln1_b[i])
        h = hier_moe(x, moe_w_grp[i], moe_b_grp[i], moe_w_rt[i], moe_b_rt[i],
                     moe_w1[i], moe_w3[i], moe_w2[i])
        x = layer_norm(DEEPNORM_ALPHA * x + h, ln2_g[i], ln2_b[i])
    return x
```

```cpp
#include <hip/hip_runtime.h>
#include <hip/hip_bf16.h>
#include <cstdio>
#include <cstdint>
#include <cmath>
namespace pg8 {
#define PG8_LAS __attribute__((address_space(3)))
typedef unsigned short bf16_t;
typedef short bf16x8 __attribute__((ext_vector_type(8)));
typedef float f32x4 __attribute__((ext_vector_type(4)));
typedef unsigned u32x4 __attribute__((ext_vector_type(4)));
typedef unsigned u32x2 __attribute__((ext_vector_type(2)));
constexpr int BM = 256, BK = 64, HALF = 128, HTB = HALF * BK * 2  , STAGE_BYTES = 8 * HTB, NXCD = 8, WGM = 8;

__host__ __device__ __forceinline__ int lds_byte(int r, int c) { const int st = (r >> 4) * 2 + (c >> 5), rr = r & 15, cc = c & 31, ob = rr * 64 + cc * 2; return st * 1024 + (ob ^ (((ob >> 9) & 1) << 5)); }
__host__ __device__ __forceinline__ void stage_rc(int b, int& R, int& C) { const int st = b / 1024, sb = b % 1024, swz = sb ^ (((sb >> 9) & 1) << 5); R = (st >> 1) * 16 + swz / 64; C = (st & 1) * 32 + (swz % 64) / 2; }
__host__ __device__ __forceinline__ int perm32(int rho) { const int n = rho >> 4, i = rho & 15; return 8 * (i >> 2) + 4 * n + (i & 3); }

struct Unit { int pm, pn, pb, gofs, gcnt; };
struct Gemm { const bf16_t* A; const bf16_t* Bt; int M, N, K; const int* rows; };

struct StaticOrder {
    int nM, nN, nwg, G, c;
    __host__ __device__ void init(int M, int N, int G_, int c_) { nM = M / BM; nN = N / BM; nwg = nM * nN; G = G_; c = c_; }
    __host__ __device__ bool next(int i, Unit& u) const {
        const long L = (long)i * G + c; if (L >= nwg) return false;
        int wgid = (int)L; { const int q = nwg / NXCD, r = nwg % NXCD, xcd = wgid % NXCD, off = wgid / NXCD; wgid = (xcd < r ? xcd * (q + 1) : r * (q + 1) + (xcd - r) * q) + off; }
        const int nig = WGM * nN, gid = wgid / nig, fm = gid * WGM, gsz = (nM - fm) < WGM ? (nM - fm) : WGM;
        u.pm = fm + ((wgid % nig) % gsz); u.pn = (wgid % nig) / gsz; u.pb = u.pn; u.gofs = 0; u.gcnt = 0; return true;
    }
};

__device__ __forceinline__ unsigned cvt_pk_bf16(float lo, float hi) { unsigned r; asm volatile("v_cvt_pk_bf16_f32 %0, %1, %2" : "=v"(r) : "v"(lo), "v"(hi)); return r; }
typedef float f32x2 __attribute__((ext_vector_type(2)));
__device__ __forceinline__ f32x2 gelu_pk(f32x2 v) {
    const f32x2 av = __builtin_elementwise_abs(v), d = av * 0.2316418882f + 1.0f;
    f32x2 t; t.x = __builtin_amdgcn_rcpf(d.x); t.y = __builtin_amdgcn_rcpf(d.y);
    f32x2 q = t * 0.5307027145f + (-0.7265760135f); q = q * t + 0.7107068705f; q = q * t + (-0.142248368f); q = q * t + 0.127414796f; q = q * t;
    const f32x2 s = (v * v) * (-0.72134752044f);
    f32x2 e; e.x = __builtin_amdgcn_exp2f(s.x); e.y = __builtin_amdgcn_exp2f(s.y);
    const f32x2 m = v * (q * e), r = v - m;
    f32x2 o; o.x = v.x < 0.f ? m.x : r.x; o.y = v.y < 0.f ? m.y : r.y; return o;
}

template <int ACT, int EXTRA> struct EpiBf16 {
    static constexpr bool PERM = true, AFTER_DRAIN = false; static_assert(ACT == 0 || ACT == 1, "EpiBf16: ACT is 0 (none) or 1 (gelu_pk)");
    bf16_t* O; int ldc; const float* bias; int split_cols; size_t split_stride; float scale0; float* xtra;
    __device__ __forceinline__ void operator()(const f32x4 (&acc)[2][2][4][2], const Unit& u, int wr, int wc, int fr, int fq) const {
        const int row0 = u.pm * BM + wr * 64 + fr; int colt = u.pn * BM; bf16_t* base = O;
        float sc = 1.f; if (split_cols) { const int t = colt / split_cols; base += (size_t)t * split_stride; colt -= t * split_cols; if (t == 0) sc = scale0; }
        const int col0 = colt + wc * 32 + 8 * fq, bcol0 = u.pn * BM + wc * 32 + 8 * fq;
        f32x4 bv[2][2];
#pragma unroll
        for (int bj = 0; bj < 2; ++bj)
#pragma unroll
            for (int n = 0; n < 2; ++n) bv[bj][n] = bias ? *(const f32x4*)(bias + bcol0 + bj * HALF + 4 * n) : (f32x4){0.f, 0.f, 0.f, 0.f};
        f32x4 cs[2][2];
        if (EXTRA == 1) {
#pragma unroll
            for (int bj = 0; bj < 2; ++bj)
#pragma unroll
                for (int n = 0; n < 2; ++n) cs[bj][n] = (f32x4){0.f, 0.f, 0.f, 0.f};
        }
        const bool vt = (EXTRA == 2) && (u.pn >= 12);
#pragma unroll
        for (int ai = 0; ai < 2; ++ai)
#pragma unroll
            for (int m = 0; m < 4; ++m) { bf16_t* rowp = base + (size_t)(row0 + ai * HALF + m * 16) * ldc + col0;
                float s1 = 0.f, s2 = 0.f;
#pragma unroll
                for (int bj = 0; bj < 2; ++bj) { f32x4 v0 = acc[ai][bj][m][0] + bv[bj][0], v1 = acc[ai][bj][m][1] + bv[bj][1];
                    if (ACT == 1) { f32x2 a = gelu_pk((f32x2){v0[0], v0[1]}), b = gelu_pk((f32x2){v0[2], v0[3]}), c = gelu_pk((f32x2){v1[0], v1[1]}), d = gelu_pk((f32x2){v1[2], v1[3]});
                        v0 = (f32x4){a.x, a.y, b.x, b.y}; v1 = (f32x4){c.x, c.y, d.x, d.y}; }
                    if (EXTRA == 1) { cs[bj][0] += v0; cs[bj][1] += v1; }
                    if (EXTRA == 2) { s1 += ((v0[0] + v0[1]) + (v0[2] + v0[3])) + ((v1[0] + v1[1]) + (v1[2] + v1[3]));
                                      s2 += ((v0[0] * v0[0] + v0[1] * v0[1]) + (v0[2] * v0[2] + v0[3] * v0[3])) + ((v1[0] * v1[0] + v1[1] * v1[1]) + (v1[2] * v1[2] + v1[3] * v1[3])); }
                    v0 = v0 * sc; v1 = v1 * sc; u32x4 w; w.x = cvt_pk_bf16(v0[0], v0[1]); w.y = cvt_pk_bf16(v0[2], v0[3]); w.z = cvt_pk_bf16(v1[0], v1[1]); w.w = cvt_pk_bf16(v1[2], v1[3]);
                    *(u32x4*)(rowp + bj * HALF) = w; }
                if (EXTRA == 2) { if (vt) { s1 += __shfl_xor(s1, 16); s1 += __shfl_xor(s1, 32); s2 += __shfl_xor(s2, 16); s2 += __shfl_xor(s2, 32);
                    if (fq == 0) *(f32x2*)(xtra + ((size_t)(row0 + ai * HALF + m * 16) * 48 + (u.pn - 12) * 4 + wc) * 2) = (f32x2){s1, s2}; } }
            }
        if (EXTRA == 1) { if (u.pn >= 4 && u.pn < 8) {
#pragma unroll
            for (int bj = 0; bj < 2; ++bj)
#pragma unroll
                for (int n = 0; n < 2; ++n) { f32x4 s = cs[bj][n];
#pragma unroll
                    for (int o = 1; o < 16; o <<= 1) { s[0] += __shfl_xor(s[0], o); s[1] += __shfl_xor(s[1], o); s[2] += __shfl_xor(s[2], o); s[3] += __shfl_xor(s[3], o); }
                    if (fr == 0) *(f32x4*)(xtra + ((size_t)wr * (16384 / 256) + u.pm) * 1024 + (u.pn - 4) * BM + bj * HALF + wc * 32 + 8 * fq + 4 * n) = s; } } }
    }
};

struct EpiMoe1 {
    static constexpr bool PERM = true, AFTER_DRAIN = false;
    bf16_t* Hb;
    __device__ __forceinline__ void operator()(const f32x4 (&acc)[2][2][4][2], const Unit& u, int wr, int wc, int fr, int fq) const {
        const int row0 = u.pm * BM + wr * 64 + fr, col0 = u.pn * HALF + wc * 32 + 8 * fq;
#pragma unroll
        for (int ai = 0; ai < 2; ++ai)
#pragma unroll
            for (int m = 0; m < 4; ++m) { bf16_t* rowp = Hb + (size_t)(row0 + ai * HALF + m * 16) * 256 + col0; float h[8];
#pragma unroll
                for (int n = 0; n < 2; ++n)
#pragma unroll
                    for (int j = 0; j < 4; ++j) { const float g = acc[ai][0][m][n][j], up = acc[ai][1][m][n][j];
                        h[n * 4 + j] = g * __builtin_amdgcn_rcpf(1.0f + __builtin_amdgcn_exp2f(-1.4426950408889634f * g)) * up; }
                u32x4 w; w.x = cvt_pk_bf16(h[0], h[1]); w.y = cvt_pk_bf16(h[2], h[3]); w.z = cvt_pk_bf16(h[4], h[5]); w.w = cvt_pk_bf16(h[6], h[7]);
                *(u32x4*)rowp = w; }
    }
};

struct PanelStats {
    unsigned* xbuf;
    unsigned* cnt;
    unsigned* tmo;
    int ntn; float eps; unsigned code;
    __device__ __forceinline__ bool run(const f32x4 (&v)[2][2][4][2], const Unit& u, int wr, int wc, int fr, int fq, PG8_LAS unsigned char* lds, int wid, int lane) const {
        typedef float f32x2v __attribute__((ext_vector_type(2)));
        PG8_LAS f32x2v* P = (PG8_LAS f32x2v*)lds;
        PG8_LAS f32x2v* S = (PG8_LAS f32x2v*)(lds + 8192);
        PG8_LAS unsigned* flag = (PG8_LAS unsigned*)(lds + 8192 + 2048);
#pragma unroll
        for (int ai = 0; ai < 2; ++ai)
#pragma unroll
            for (int m = 0; m < 4; ++m) {
                float s = 0.f;
#pragma unroll
                for (int bj = 0; bj < 2; ++bj)
#pragma unroll
                    for (int n = 0; n < 2; ++n) { const f32x4 x = v[ai][bj][m][n]; s += (x[0] + x[1]) + (x[2] + x[3]); }
                s += __shfl_xor(s, 16); s += __shfl_xor(s, 32);
                const float mw = s * (1.0f / 64.0f); float q = 0.f;
#pragma unroll
                for (int bj = 0; bj < 2; ++bj)
#pragma unroll
                    for (int n = 0; n < 2; ++n) { const f32x4 d = v[ai][bj][m][n] - mw; q += (d[0] * d[0] + d[1] * d[1]) + (d[2] * d[2] + d[3] * d[3]); }
                q += __shfl_xor(q, 16); q += __shfl_xor(q, 32);
                if (fq == 0) P[(ai * HALF + wr * 64 + m * 16 + fr) * 4 + wc] = (f32x2v){mw, q};
            }
        asm volatile("s_waitcnt lgkmcnt(0)" ::: "memory"); __builtin_amdgcn_s_barrier(); asm volatile("" ::: "memory");
        const int row = wid * 32 + (lane & 31);
        if (lane < 32) {
            const f32x2v a = P[row * 4 + 0], b = P[row * 4 + 1], c = P[row * 4 + 2], d = P[row * 4 + 3];
            const float mt = (a.x + b.x + c.x + d.x) * 0.25f;
            const float da = a.x - mt, db = b.x - mt, dc = c.x - mt, dd = d.x - mt;
            const float m2 = (a.y + b.y) + (c.y + d.y) + 64.0f * ((da * da + db * db) + (dc * dc + dd * dd));
            unsigned long long* slot = (unsigned long long*)xbuf + ((size_t)(u.pm * BM + row) * 4 + u.pn);
            __hip_atomic_store(slot, ((unsigned long long)__float_as_uint(m2) << 32) | __float_as_uint(mt), __ATOMIC_RELAXED, __HIP_MEMORY_SCOPE_AGENT);
        }
        asm volatile("s_waitcnt vmcnt(0)" ::: "memory");
        if (lane == 0) __hip_atomic_fetch_add(cnt + 64 * u.pm, 1u, __ATOMIC_RELAXED, __HIP_MEMORY_SCOPE_AGENT);
        if (wid == 0) {
            bool dead = false; const unsigned long long t0 = __builtin_amdgcn_s_memrealtime(); const unsigned want = 8u * (unsigned)ntn;
            for (;;) {
                if ((unsigned)__builtin_amdgcn_readfirstlane(__hip_atomic_load(cnt + 64 * u.pm, __ATOMIC_RELAXED, __HIP_MEMORY_SCOPE_AGENT)) >= want) break;
                if (__builtin_amdgcn_s_memrealtime() - t0 > 2000000ull) {
                    if (lane == 0) { unsigned expect = 0u; __hip_atomic_compare_exchange_strong(tmo + 1, &expect, code | (unsigned)(u.pm & 0xff), __ATOMIC_RELAXED, __ATOMIC_RELAXED, __HIP_MEMORY_SCOPE_AGENT);
                                     __hip_atomic_store(tmo, 1u, __ATOMIC_RELAXED, __HIP_MEMORY_SCOPE_AGENT); }
                    dead = true; break; }
                __builtin_amdgcn_s_sleep(2);
            }
            __builtin_amdgcn_fence(__ATOMIC_ACQUIRE, "agent");
            if (lane == 0) flag[0] = dead ? 1u : 0u;
        }
        asm volatile("s_waitcnt vmcnt(0) lgkmcnt(0)" ::: "memory"); __builtin_amdgcn_s_barrier(); asm volatile("" ::: "memory");
        const bool bad = flag[0] != 0u;
        if (lane < 32) {
            const unsigned long long* slot = (const unsigned long long*)xbuf + (size_t)(u.pm * BM + row) * 4; float mt[4], m2[4]; float ms = 0.f;
#pragma unroll
            for (int t = 0; t < 4; ++t) { if (t < ntn) { const unsigned long long w = __hip_atomic_load(slot + t, __ATOMIC_RELAXED, __HIP_MEMORY_SCOPE_AGENT); mt[t] = __uint_as_float((unsigned)w); m2[t] = __uint_as_float((unsigned)(w >> 32)); } else { mt[t] = 0.f; m2[t] = 0.f; } ms += mt[t]; }
            const float mean = ms / (float)ntn; float q = 0.f;
#pragma unroll
            for (int t = 0; t < 4; ++t) if (t < ntn) { const float dm = mt[t] - mean; q += m2[t] + 256.0f * dm * dm; }
            S[row] = (f32x2v){mean, 1.0f / sqrtf(q / (256.0f * (float)ntn) + eps)};
        }
        asm volatile("s_waitcnt lgkmcnt(0)" ::: "memory"); __builtin_amdgcn_s_barrier(); asm volatile("" ::: "memory");
        return bad;
    }
};
struct EpiLn1 {
    static constexpr bool PERM = false, AFTER_DRAIN = true;
    bf16_t* X; const float* gamma; const float* beta; float alpha; PanelStats st;
    __device__ __forceinline__ void fused(f32x4 (&acc)[2][2][4][2], const Unit& u, int wr, int wc, int fr, int fq, PG8_LAS unsigned char* lds, int wid, int lane) const {
        typedef float f32x2v __attribute__((ext_vector_type(2)));
        const PG8_LAS f32x2v* S = (const PG8_LAS f32x2v*)(lds + 8192);
        const int col0 = u.pn * BM + wc * 32 + 4 * fq;
#pragma unroll
        for (int ai = 0; ai < 2; ++ai)
#pragma unroll
            for (int m = 0; m < 4; ++m) { const size_t off = (size_t)(u.pm * BM + ai * HALF + wr * 64 + m * 16 + fr) * 1024 + col0;
#pragma unroll
                for (int bj = 0; bj < 2; ++bj)
#pragma unroll
                    for (int n = 0; n < 2; ++n) { const u32x2 b = *(const u32x2*)(X + off + bj * HALF + n * 16);
                        const f32x4 bs = (f32x4){__uint_as_float(b.x << 16), __uint_as_float(b.x & 0xffff0000u), __uint_as_float(b.y << 16), __uint_as_float(b.y & 0xffff0000u)};
                        acc[ai][bj][m][n] += bs * alpha; }
                if (m & 1) asm volatile("" ::: "memory"); }
        (void)st.run(acc, u, wr, wc, fr, fq, lds, wid, lane);
        f32x4 gv[2][2], bv[2][2];
#pragma unroll
        for (int bj = 0; bj < 2; ++bj)
#pragma unroll
            for (int n = 0; n < 2; ++n) { gv[bj][n] = *(const f32x4*)(gamma + col0 + bj * HALF + n * 16); bv[bj][n] = *(const f32x4*)(beta + col0 + bj * HALF + n * 16); }
#pragma unroll
        for (int ai = 0; ai < 2; ++ai)
#pragma unroll
            for (int m = 0; m < 4; ++m) { const int r = ai * HALF + wr * 64 + m * 16 + fr; const f32x2v sr = S[r]; const size_t off = (size_t)(u.pm * BM + r) * 1024 + col0;
#pragma unroll
                for (int bj = 0; bj < 2; ++bj)
#pragma unroll
                    for (int n = 0; n < 2; ++n) { const f32x4 o = (acc[ai][bj][m][n] - sr.x) * sr.y * gv[bj][n] + bv[bj][n];
                        u32x2 w; w.x = cvt_pk_bf16(o[0], o[1]); w.y = cvt_pk_bf16(o[2], o[3]); *(u32x2*)(X + off + bj * HALF + n * 16) = w; } }
    }
};

template <class Epi, class Sched, bool ALIGN_EPI = false, bool SP2 = false, bool GATHER = false>
__device__ __forceinline__ void gemm_phase(PG8_LAS unsigned char* lds, const Gemm g, const Sched& S, const Epi& E, const int tid) {
    const int wid = __builtin_amdgcn_readfirstlane(tid >> 6), lane = tid & 63, wr = wid >> 2, wc = wid & 3, fr = lane & 15, fq = lane >> 4;
    const int K = g.K, nt = K / BK;
    unsigned voffA[2], voffB[2]; int gR[2], gC[2];
#pragma unroll
    for (int i = 0; i < 2; ++i) { int R, C; stage_rc(tid * 16 + i * 8192, R, C); const int Rb = Epi::PERM ? ((R & ~31) + perm32(R & 31)) : R;
        voffA[i] = (unsigned)(R * K + C) * 2u; voffB[i] = (unsigned)(Rb * K + C) * 2u; gR[i] = R; gC[i] = C; }
    const size_t kstep = (size_t)(BK * 2);
    const size_t hstep = (size_t)HALF * K * 2;
    const size_t tstep = 2 * hstep;
    const unsigned ldsw = (unsigned)wid * 1024u;
    const int aoff = lds_byte(wr * 64 + fr, fq * 8), boff = lds_byte(wc * 32 + fr, fq * 8);
    unsigned voA[2][2], voAn[2][2];
#define PG8_GOFF(vo, uu) do { if constexpr (GATHER) { _Pragma("unroll") for (int _h = 0; _h < 2; ++_h) _Pragma("unroll") for (int _i = 0; _i < 2; ++_i) { \
        const int _r = _h * HALF + gR[_i]; int _tk = 0; if (_r < (uu).gcnt) _tk = g.rows[(uu).gofs + _r]; (vo)[_h][_i] = (unsigned)(_tk * K + gC[_i]) * 2u; } } } while (0)
#define PG8_SA(b, h) (((b) * 2 + (h)) * HTB)
#define PG8_SB(b, h) ((4 + (b) * 2 + (h)) * HTB)
#define PG8_STAGE(bufoff, gbase, voff) do { _Pragma("unroll") for (int _i = 0; _i < 2; ++_i) \
        __builtin_amdgcn_global_load_lds((const unsigned*)((const char*)(gbase) + (voff)[_i]), (PG8_LAS unsigned*)(lds + (bufoff) + ldsw + _i * 8192), 16, 0, 0); } while (0)
#define PG8_STA(b, h, kp, NX) do { if constexpr (GATHER) { unsigned _o[2]; _o[0] = (NX) ? voAn[h][0] : voA[h][0]; _o[1] = (NX) ? voAn[h][1] : voA[h][1]; PG8_STAGE(PG8_SA(b, h), (kp), _o); } \
        else { PG8_STAGE(PG8_SA(b, h), (kp) + (h) * hstep, voffA); } } while (0)
#define PG8_LDA(dst, b, h) do { _Pragma("unroll") for (int m = 0; m < 4; ++m) _Pragma("unroll") for (int k = 0; k < 2; ++k) dst[m][k] = *(const PG8_LAS bf16x8*)(lds + PG8_SA(b, h) + aoff + m * 2048 + k * 1024); } while (0)
#define PG8_LDB(dst, b, h) do { _Pragma("unroll") for (int n = 0; n < 2; ++n) _Pragma("unroll") for (int k = 0; k < 2; ++k) dst[n][k] = *(const PG8_LAS bf16x8*)(lds + PG8_SB(b, h) + boff + n * 2048 + k * 1024); } while (0)
#define PG8_MMA(ai, bj, At, Bt) do { __builtin_amdgcn_s_setprio(1); _Pragma("unroll") for (int m = 0; m < 4; ++m) _Pragma("unroll") for (int n = 0; n < 2; ++n) _Pragma("unroll") for (int k = 0; k < 2; ++k) \
        acc[ai][bj][m][n] = __builtin_amdgcn_mfma_f32_16x16x32_bf16(Bt[n][k], At[m][k], acc[ai][bj][m][n], 0, 0, 0); __builtin_amdgcn_s_setprio(0); } while (0)
#define PG8_WAIT_V(n) asm volatile("s_waitcnt vmcnt(" #n ")" ::: "memory")
#define PG8_WAIT_L(n) asm volatile("s_waitcnt lgkmcnt(" #n ")" ::: "memory")
#define PG8_BAR __builtin_amdgcn_s_barrier()
#define PG8_SCHED __builtin_amdgcn_sched_barrier(0)
    Unit cur, nxt; int ui = 0;
    if (!S.next(0, cur)) return;
    f32x4 acc[2][2][4][2];
#pragma unroll
    for (int a = 0; a < 2; ++a)
#pragma unroll
        for (int b = 0; b < 2; ++b)
#pragma unroll
            for (int m = 0; m < 4; ++m)
#pragma unroll
                for (int n = 0; n < 2; ++n) acc[a][b][m][n] = (f32x4){0.f, 0.f, 0.f, 0.f};
    bf16x8 At[4][2], B0[2][2], B1[2][2];
    const char* cA = GATHER ? (const char*)g.A : (const char*)g.A + (size_t)cur.pm * tstep; const char* cB = (const char*)g.Bt + (size_t)cur.pb * tstep;
    PG8_GOFF(voA, cur);
    if constexpr (GATHER) { _Pragma("unroll") for (int _h = 0; _h < 2; ++_h) _Pragma("unroll") for (int _i = 0; _i < 2; ++_i) voAn[_h][_i] = voA[_h][_i]; }
    if constexpr (SP2) {
        PG8_STAGE(PG8_SB(0, 0), cB, voffB); PG8_STAGE(PG8_SB(0, 1), cB + hstep, voffB); PG8_STA(0, 0, cA, false); PG8_STA(0, 1, cA, false);
        if (wr == 1) PG8_BAR;
        PG8_WAIT_V(2); PG8_BAR;
        PG8_STAGE(PG8_SB(1, 0), cB + kstep, voffB); PG8_STA(1, 0, cA + kstep, false); PG8_STAGE(PG8_SB(1, 1), cB + hstep + kstep, voffB);
        PG8_WAIT_V(6); PG8_BAR;
    } else {
        PG8_STAGE(PG8_SB(0, 0), cB, voffB); PG8_STA(0, 0, cA, false); PG8_STAGE(PG8_SB(0, 1), cB + hstep, voffB); PG8_STA(0, 1, cA, false);
        if (wr == 1) PG8_BAR;
        PG8_WAIT_V(4); PG8_BAR;
        PG8_STAGE(PG8_SB(1, 0), cB + kstep, voffB); PG8_STA(1, 0, cA + kstep, false); PG8_STAGE(PG8_SB(1, 1), cB + hstep + kstep, voffB);
        PG8_WAIT_V(6); PG8_BAR;
    }
    for (;;) {
        const bool has_next = S.next(ui + 1, nxt);
        if constexpr (GATHER) { if (has_next) { PG8_GOFF(voAn, nxt); asm volatile("s_waitcnt vmcnt(0)" ::: "memory"); } }
        const char* nA = GATHER ? cA : (has_next ? (const char*)g.A + (size_t)nxt.pm * tstep : cA); const char* nB = has_next ? (const char*)g.Bt + (size_t)nxt.pb * tstep : cB;
        for (int t = 0; t < nt; t += 2) {
            const bool last = (t == nt - 2);
            const bool NX = last && has_next;
            const char* a1 = cA + (size_t)(t + 1) * kstep;
            const char* a2 = last ? nA : cA + (size_t)(t + 2) * kstep; const char* b2 = last ? nB : cB + (size_t)(t + 2) * kstep;
            const char* a3 = a2 + kstep; const char* b3 = b2 + kstep;
            if constexpr (SP2) {
            PG8_LDB(B0, 0, 0); PG8_LDB(B1, 0, 1); PG8_SCHED; PG8_LDA(At, 0, 0); PG8_STA(1, 1, a1, false);
            PG8_WAIT_V(8); PG8_WAIT_L(0); PG8_BAR; PG8_MMA(0, 0, At, B0); PG8_MMA(0, 1, At, B1); PG8_BAR; PG8_SCHED;
            PG8_LDA(At, 0, 1); PG8_STAGE(PG8_SB(0, 0), b2, voffB); PG8_STAGE(PG8_SB(0, 1), b2 + hstep, voffB); PG8_STA(0, 0, a2, NX);
            PG8_WAIT_V(8); PG8_WAIT_L(0); PG8_BAR; PG8_MMA(1, 0, At, B0); PG8_MMA(1, 1, At, B1); PG8_BAR; PG8_SCHED;
            PG8_LDB(B0, 1, 0); PG8_LDB(B1, 1, 1); PG8_SCHED; PG8_LDA(At, 1, 0); PG8_STA(0, 1, a2, NX);
            PG8_WAIT_V(8); PG8_WAIT_L(0); PG8_BAR; PG8_MMA(0, 0, At, B0); PG8_MMA(0, 1, At, B1); PG8_BAR; PG8_SCHED;
            PG8_LDA(At, 1, 1); PG8_STAGE(PG8_SB(1, 0), b3, voffB); PG8_STAGE(PG8_SB(1, 1), b3 + hstep, voffB); PG8_STA(1, 0, a3, NX);
            PG8_WAIT_V(8); PG8_WAIT_L(0); PG8_BAR; PG8_MMA(1, 0, At, B0); PG8_MMA(1, 1, At, B1); PG8_BAR; PG8_SCHED;
            } else {
            PG8_LDB(B0, 0, 0); PG8_SCHED; PG8_LDA(At, 0, 0); PG8_STA(1, 1, a1, false);
            PG8_WAIT_L(8); PG8_BAR; PG8_WAIT_L(0); PG8_MMA(0, 0, At, B0); PG8_BAR; PG8_SCHED;
            PG8_LDB(B1, 0, 1); PG8_STAGE(PG8_SB(0, 0), b2, voffB);
            PG8_BAR; PG8_WAIT_L(0); PG8_MMA(0, 1, At, B1); PG8_BAR;
            PG8_LDA(At, 0, 1); PG8_STA(0, 0, a2, NX);
            PG8_BAR; PG8_WAIT_L(0); PG8_MMA(1, 0, At, B0); PG8_BAR; PG8_SCHED;
            PG8_STAGE(PG8_SB(0, 1), b2 + hstep, voffB);
            PG8_WAIT_V(6); PG8_BAR; PG8_MMA(1, 1, At, B1); PG8_BAR;
            PG8_LDB(B0, 1, 0); PG8_SCHED; PG8_LDA(At, 1, 0); PG8_STA(0, 1, a2, NX);
            PG8_WAIT_L(8); PG8_BAR; PG8_WAIT_L(0); PG8_MMA(0, 0, At, B0); PG8_BAR; PG8_SCHED;
            PG8_LDB(B1, 1, 1); PG8_STAGE(PG8_SB(1, 0), b3, voffB);
            PG8_BAR; PG8_WAIT_L(0); PG8_MMA(0, 1, At, B1); PG8_BAR;
            PG8_LDA(At, 1, 1); PG8_STA(1, 0, a3, NX);
            PG8_BAR; PG8_WAIT_L(0); PG8_MMA(1, 0, At, B0); PG8_BAR; PG8_SCHED;
            PG8_STAGE(PG8_SB(1, 1), b3 + hstep, voffB);
            PG8_WAIT_V(6); PG8_BAR; PG8_MMA(1, 1, At, B1); PG8_BAR;
            }
        }
        if constexpr (ALIGN_EPI) { if (wr == 0) PG8_BAR; }
        if constexpr (!Epi::AFTER_DRAIN) { int t2 = tid; asm volatile("" : "+v"(t2)); const int l2 = t2 & 63; E(acc, cur, wr, wc, l2 & 15, l2 >> 4); }
        if (!has_next) break;
#pragma unroll
        for (int a = 0; a < 2; ++a)
#pragma unroll
            for (int b = 0; b < 2; ++b)
#pragma unroll
                for (int m = 0; m < 4; ++m)
#pragma unroll
                    for (int n = 0; n < 2; ++n) acc[a][b][m][n] = (f32x4){0.f, 0.f, 0.f, 0.f};
        cur = nxt; cA = nA; cB = nB; ++ui;
        if constexpr (GATHER) { _Pragma("unroll") for (int _h = 0; _h < 2; ++_h) _Pragma("unroll") for (int _i = 0; _i < 2; ++_i) voA[_h][_i] = voAn[_h][_i]; }
        if constexpr (ALIGN_EPI) { if (wr == 1) PG8_BAR; }
    }
    PG8_WAIT_V(0);
    if constexpr (!ALIGN_EPI) { if (wr == 0) PG8_BAR; }
    PG8_BAR;
    if constexpr (Epi::AFTER_DRAIN) { int t2 = tid; asm volatile("" : "+v"(t2)); const int l2 = t2 & 63; E.fused(acc, cur, wr, wc, l2 & 15, l2 >> 4, lds, wid, l2); }
#undef PG8_GOFF
#undef PG8_SA
#undef PG8_SB
#undef PG8_STAGE
#undef PG8_STA
#undef PG8_LDA
#undef PG8_LDB
#undef PG8_MMA
#undef PG8_WAIT_V
#undef PG8_WAIT_L
#undef PG8_BAR
#undef PG8_SCHED
}
}
#define GAS __attribute__((address_space(1)))
#define LAS __attribute__((address_space(3)))
typedef unsigned short bf16;
typedef unsigned v4u __attribute__((ext_vector_type(4)));
typedef float f32x4 __attribute__((ext_vector_type(4)));
typedef short bf16x8 __attribute__((ext_vector_type(8)));
typedef GAS unsigned gu32;
typedef GAS unsigned long long gu64;
#define RLX_AGENT __ATOMIC_RELAXED, __HIP_MEMORY_SCOPE_AGENT
#define LDS_WAIT() asm volatile("s_waitcnt lgkmcnt(0)" ::: "memory")
#define VM_WAIT() asm volatile("s_waitcnt vmcnt(0)" ::: "memory")
__device__ __forceinline__ unsigned long long rt() { return __builtin_amdgcn_s_memrealtime(); }
__device__ __forceinline__ unsigned f2bf(float f) { unsigned u = __builtin_bit_cast(unsigned, f); return (u + 0x7fffu + ((u >> 16) & 1u)) >> 16; }
__device__ __forceinline__ unsigned pk2(float lo, float hi) { return f2bf(lo) | (f2bf(hi) << 16); }

#define XB_TMO      128
#define XB_XCNT(j)  (256  + 64 * (j))
#define XB_XSUB(j)  (1280 + 64 * (j))
#define XB_XGEN(j)  (2304 + 64 * (j))
#define XB_TOP      3328
#define XB_TOPGEN   3392
#define XCD_BAR_WORDS 3456
#define XB_SPIN_CAP (1u << 18)

__device__ __forceinline__ unsigned xb_ld(unsigned* p)              { return __hip_atomic_load(p, __ATOMIC_RELAXED, __HIP_MEMORY_SCOPE_AGENT); }
__device__ __forceinline__ unsigned xb_add(unsigned* p, unsigned v) { return __hip_atomic_fetch_add(p, v, __ATOMIC_RELAXED, __HIP_MEMORY_SCOPE_AGENT); }
__device__ __forceinline__ unsigned xb_xcc_id() { return (unsigned)__builtin_amdgcn_s_getreg((3 << 11) | 20) & 0xFu; }
#define XB_SPIN(cond, bar) do { unsigned _sp = 0; while (cond) { __builtin_amdgcn_s_sleep(1); \
    if ((++_sp & 255u) == 0u) { if (xb_ld(&(bar)[XB_TMO])) break; if (_sp > XB_SPIN_CAP) { atomicAdd(&(bar)[XB_TMO], 1u); break; } } } } while (0)

struct XcdBarrier {
    unsigned* bar; unsigned x;
    volatile LAS unsigned* st;
};

__device__ __forceinline__ XcdBarrier xcd_barrier_post(unsigned* bar, volatile LAS unsigned* st) {
    XcdBarrier b; b.bar = bar; b.x = xb_xcc_id(); b.st = st;
    if (threadIdx.x == 0) (void)xb_add(&bar[XB_XCNT(b.x)], 1u);
    return b;
}
__device__ __forceinline__ void xcd_barrier_complete(unsigned* bar, unsigned x, unsigned& nloc, unsigned& nx) {
    const unsigned G = gridDim.x * gridDim.y * gridDim.z;
    unsigned sum, cnt, mine, sp = 0u;
    for (;;) {
        sum = 0u; cnt = 0u; mine = 0u;
#pragma unroll
        for (unsigned j = 0; j < 16; ++j) { const unsigned c = xb_ld(&bar[XB_XCNT(j)]); sum += c; cnt += (c > 0u) ? 1u : 0u; mine = (j == x) ? c : mine; }
        if (sum == G) break;
        __builtin_amdgcn_s_sleep(1);
        if ((++sp & 255u) == 0u) { if (xb_ld(&bar[XB_TMO])) break; if (sp > XB_SPIN_CAP) { atomicAdd(&bar[XB_TMO], 1u); break; } }
    }
    nloc = mine > 0u ? mine : 1u; nx = cnt > 0u ? cnt : 1u;
}

__device__ __forceinline__ void xcd_barrier(const XcdBarrier& b) {
    asm volatile("s_waitcnt vmcnt(0)" ::: "memory");
    __syncthreads();
    if (threadIdx.x == 0) {
        unsigned* bar = b.bar;
        __builtin_amdgcn_s_waitcnt(0);
        unsigned nloc = b.st[0], nx = b.st[1];
        if (nloc == 0u) { xcd_barrier_complete(bar, b.x, nloc, nx); b.st[0] = nloc; b.st[1] = nx; }
        const unsigned old = xb_add(&bar[XB_XSUB(b.x)], 1u);
        const unsigned gen = old / nloc;
        if (old + 1u == (gen + 1u) * nloc) {
            __builtin_amdgcn_fence(__ATOMIC_RELEASE, "agent");
            asm volatile("s_waitcnt vmcnt(0)" ::: "memory");
            const unsigned og = xb_add(&bar[XB_TOP], 1u);
            const unsigned tg = og / nx;
            if (og + 1u == (tg + 1u) * nx) xb_add(&bar[XB_TOPGEN], 1u);
            else XB_SPIN(xb_ld(&bar[XB_TOPGEN]) == tg, bar);
            __builtin_amdgcn_fence(__ATOMIC_ACQUIRE, "agent");
            xb_add(&bar[XB_XGEN(b.x)], 1u);
            asm volatile("s_waitcnt vmcnt(0)" ::: "memory");
        } else {
            XB_SPIN(xb_ld(&bar[XB_XGEN(b.x)]) == gen, bar);
            __builtin_amdgcn_fence(__ATOMIC_ACQUIRE, "agent");
            asm volatile("s_waitcnt vmcnt(0)" ::: "memory");
        }
    }
    __syncthreads();
}
constexpr int NWAVES = 8;
constexpr int BATCH = 8, SEQ = 2048, D = 1024, NH = 16, HD = 64, DEPTH = 4;
constexpr int M = BATCH * SEQ;
constexpr int NQKV = 3 * D, DV = 3072, NZ = 2 * DV, GG = 8, GD = 384, CHK = 128;
constexpr int NE = 64, EPG = 8, FE = 256, NRT = 80;
constexpr float LN_EPS = 1e-5f, ALPHA = 1.681792830507429f;
constexpr float QSCALE = 0.125f * 1.4426950408889634f;
constexpr int TOKCAP = 16384;
constexpr int MAXTILES = 192;

constexpr size_t MiB = 1u << 20;
constexpr size_t WS_CTL = 0, CTL_ZERO_BYTES = 1 * MiB;
constexpr size_t WS_WQKV = 2 * MiB;
constexpr size_t WS_WO = 14 * MiB;
constexpr size_t WS_WIN = 18 * MiB;
constexpr size_t WS_WOUT = 42 * MiB;
constexpr size_t WS_WR = 54 * MiB;
constexpr size_t WS_XB = 56 * MiB;
constexpr size_t WS_KSUM = 57 * MiB;
constexpr size_t WS_VPART = 58 * MiB;
constexpr size_t WS_TOK = 64 * MiB;
constexpr size_t WS_ASG = 68 * MiB;
constexpr size_t WS_XN = 72 * MiB;
constexpr size_t WS_QO = 104 * MiB, WS_K = 136 * MiB, WS_V = 168 * MiB;
constexpr size_t WS_U = 104 * MiB, WS_VV = 200 * MiB;
constexpr size_t WS_HB = 296 * MiB;
constexpr size_t WS_YB = 320 * MiB;
constexpr size_t WS_W13 = 416 * MiB;
constexpr size_t WS_W2 = 672 * MiB;
constexpr size_t WS_END = 800 * MiB;
constexpr int CW_TMO = 0, CW_CODE = 1;
constexpr int CW_BAR = 4096;
constexpr int CW_SEAM = 16384;
constexpr int CW_CNT = 32768;
constexpr int RING_OFF = 0, RING_BYTES = 131072;
constexpr int LDSCTL_OFF = RING_BYTES, MISC_OFF = LDSCTL_OFF + 320;
constexpr int TAB_OFF = LDSCTL_OFF + 1024;
constexpr int LDS_BYTES = 147456;

struct Args { const float* in[21]; float* out; unsigned char* ws; int ph_lo, ph_hi; };
struct Frame {
    LAS unsigned char* lds;
    volatile LAS unsigned* MISC;
    gu32* ctl;
    int tid, lane, wave;
    int vcu, G;
    float* out; unsigned char* ws;
    bf16 *XN, *QO, *KB, *VB, *UB, *VVB, *HB, *YB;
};
__device__ __forceinline__ float wave_sum(float v) {
#pragma unroll
    for (int o = 1; o < 64; o <<= 1) v += __shfl_xor(v, o);
    return v;
}
__device__ __forceinline__ float bflo(unsigned w) { return __uint_as_float(w << 16); }
__device__ __forceinline__ float bfhi(unsigned w) { return __uint_as_float(w & 0xffff0000u); }
template <class T> __device__ __forceinline__ T* opaque(T* p) { asm volatile("" : "+v"(p)); return p; }

__device__ __forceinline__ void p0_transpose_tile(const float* W, int N, int k0, int n0, bf16* WTrow, int ldt, LAS float* scr, int lane) {
#pragma unroll 4
    for (int i = 0; i < 32; ++i) { const int kk = 2 * i + (lane >> 5); scr[kk * 33 + (lane & 31)] = W[(size_t)(k0 + kk) * N + n0 + (lane & 31)]; }
    LDS_WAIT(); asm volatile("" ::: "memory");
    const int c = lane & 7;
#pragma unroll
    for (int j = 0; j < 4; ++j) { const int n = (lane >> 3) + 8 * j; const LAS float* s = scr + (8 * c) * 33 + n;
        v4u o; o.x = pk2(s[0 * 33], s[1 * 33]); o.y = pk2(s[2 * 33], s[3 * 33]); o.z = pk2(s[4 * 33], s[5 * 33]); o.w = pk2(s[6 * 33], s[7 * 33]);
        *(GAS v4u*)(WTrow + (size_t)n * ldt + k0 + 8 * c) = o; }
    LDS_WAIT(); asm volatile("" ::: "memory");
}
__device__ __forceinline__ void p0_prologue(Frame& F, const Args& A) {
    LAS float* scr = (LAS float*)(F.lds + RING_OFF + F.wave * 16384);
    const int gw = F.vcu * NWAVES + F.wave, NGW = F.G * NWAVES;
    unsigned char* ws = F.ws;
    constexpr int I_QKV = 16 * 96, I_WO = 16 * 32, I_WIN = 16 * 192, I_WOUT = 48 * 32, I_DENSE = 2 * (I_QKV + I_WO + I_WIN + I_WOUT);
    constexpr int I_E = 128, I_MOE = DEPTH * NE * 3 * I_E;
    for (int it = gw; it < I_DENSE + I_MOE; it += NGW) {
        int r = it;
        if (r < I_DENSE) {
            if (r < 2 * I_QKV) { const int j = r / I_QKV; r %= I_QKV; const int kb = r / 96, nb = r % 96;
                p0_transpose_tile(A.in[1] + (size_t)j * D * NQKV, NQKV, kb * 64, nb * 32, (bf16*)(ws + WS_WQKV) + (size_t)j * NQKV * D + (size_t)(nb * 32) * D, D, scr, F.lane); continue; } r -= 2 * I_QKV;
            if (r < 2 * I_WO) { const int j = r / I_WO; r %= I_WO; const int kb = r / 32, nb = r % 32;
                p0_transpose_tile(A.in[2] + (size_t)j * D * D, D, kb * 64, nb * 32, (bf16*)(ws + WS_WO) + (size_t)j * D * D + (size_t)(nb * 32) * D, D, scr, F.lane); continue; } r -= 2 * I_WO;
            if (r < 2 * I_WIN) { const int j = r / I_WIN; r %= I_WIN; const int kb = r / 192, nb = r % 192;
                p0_transpose_tile(A.in[3] + (size_t)j * D * NZ, NZ, kb * 64, nb * 32, (bf16*)(ws + WS_WIN) + (size_t)j * NZ * D + (size_t)(nb * 32) * D, D, scr, F.lane); continue; } r -= 2 * I_WIN;
            { const int j = r / I_WOUT; r %= I_WOUT; const int kb = r / 32, nb = r % 32;
                p0_transpose_tile(A.in[9] + (size_t)j * DV * D, D, kb * 64, nb * 32, (bf16*)(ws + WS_WOUT) + (size_t)j * D * DV + (size_t)(nb * 32) * DV, DV, scr, F.lane); continue; }
        }
        r -= I_DENSE;
        const int le = r / (3 * I_E); r %= 3 * I_E; const int which = r / I_E; r %= I_E;
        if (which < 2) {
            const int kb = r / 8, nb = r % 8, n0 = nb * 32;
            p0_transpose_tile(A.in[18 + which] + (size_t)le * D * FE, FE, kb * 64, n0, (bf16*)(ws + WS_W13) + (size_t)le * 512 * D + (size_t)((n0 >> 7) * 256 + which * 128 + (n0 & 127)) * D, D, scr, F.lane);
        } else {
            const int kb = r / 32, nb = r % 32;
            p0_transpose_tile(A.in[20] + (size_t)le * FE * D, D, kb * 64, nb * 32, (bf16*)(ws + WS_W2) + (size_t)le * D * FE + (size_t)(nb * 32) * FE, FE, scr, F.lane);
        }
    }
    const int gt = F.vcu * (NWAVES * 64) + F.tid, NGT = F.G * NWAVES * 64;
    for (int idx = gt; idx < DEPTH * NRT * D; idx += NGT) {
        const int l = idx / (NRT * D), n = (idx / D) % NRT, k = idx % D;
        float w = 0.f; if (n < 8) w = A.in[14][((size_t)l * D + k) * 8 + n]; else if (n < 72) w = A.in[16][((size_t)l * D + k) * NE + (n - 8)];
        const unsigned hi = f2bf(w); const float lo = w - __uint_as_float(hi << 16);
        bf16* wr = (bf16*)(ws + WS_WR) + (size_t)l * 2 * NRT * D + (size_t)n * D + k;
        wr[0] = (bf16)hi; wr[(size_t)NRT * D] = (bf16)f2bf(lo);
    }
    for (int idx = gt; idx < M * D / 8; idx += NGT) {
        const f32x4 a = ((const f32x4*)A.in[0])[2 * idx], b = ((const f32x4*)A.in[0])[2 * idx + 1];
        v4u o; o.x = pk2(a[0], a[1]); o.y = pk2(a[2], a[3]); o.z = pk2(b[0], b[1]); o.w = pk2(b[2], b[3]);
        ((GAS v4u*)F.XN)[idx] = o;
    }
}

__device__ __forceinline__ void attn_naive_phase(Frame& F) {
    const int gw = F.vcu * NWAVES + F.wave, NGW = F.G * NWAVES;
    const float* ks = (const float*)(F.ws + WS_KSUM);
    for (int wu = gw; wu < BATCH * NH * (SEQ / 64); wu += NGW) {
        const int bh = wu / (SEQ / 64), qc = wu % (SEQ / 64), b = bh / NH, h = bh % NH;
        const int q = qc * 64 + F.lane, qb = (qc * 64) >> 8;
        const size_t rowq = (size_t)b * SEQ + q;
        unsigned qp[32];
        { const v4u* qg = (const v4u*)(F.QO + rowq * D + h * HD);
#pragma unroll
          for (int c = 0; c < 8; ++c) { const v4u w = qg[c]; qp[4 * c + 0] = w.x; qp[4 * c + 1] = w.y; qp[4 * c + 2] = w.z; qp[4 * c + 3] = w.w; } }
        unsigned sel = (1u << qb) - 1u;
        if (qb > 3) {
            float t0 = -INFINITY, t1 = -INFINITY, t2 = -INFINITY; int i0 = 0, i1 = 0, i2 = 0;
#pragma unroll 1
            for (int j = 0; j < qb; ++j) {
                const f32x4* k0 = opaque((const f32x4*)(ks + ((size_t)(b * 8 + j)) * 1024 + h * HD)); const f32x4* k1 = k0 + (size_t)64 * 256; float s = 0.f;
#pragma unroll
                for (int c = 0; c < 8; ++c) { const f32x4 a0 = k0[2 * c] + k1[2 * c], a1 = k0[2 * c + 1] + k1[2 * c + 1];
                    s += bflo(qp[4 * c + 0]) * a0[0] + bfhi(qp[4 * c + 0]) * a0[1] + bflo(qp[4 * c + 1]) * a0[2] + bfhi(qp[4 * c + 1]) * a0[3]
                       + bflo(qp[4 * c + 2]) * a1[0] + bfhi(qp[4 * c + 2]) * a1[1] + bflo(qp[4 * c + 3]) * a1[2] + bfhi(qp[4 * c + 3]) * a1[3]; }
                asm volatile("" : "+v"(s));
                if (s > t0) { t2 = t1; i2 = i1; t1 = t0; i1 = i0; t0 = s; i0 = j; } else if (s > t1) { t2 = t1; i2 = i1; t1 = s; i1 = j; } else if (s > t2) { t2 = s; i2 = j; }
            }
            sel = (1u << i0) | (1u << i1) | (1u << i2);
        }
        float mx = -INFINITY, l = 0.f, o[64];
#pragma unroll
        for (int d = 0; d < 64; ++d) o[d] = 0.f;
        for (int j = 0; j <= qb; ++j) {
            const bool use = (j == qb) || ((sel >> j) & 1u);
            const int kend = (j == qb) ? (qc * 64 + 64 - qb * 256) : 256;
#pragma unroll 1
            for (int kk = 0; kk < kend; ++kk) {
                const int key = j * 256 + kk;
                const v4u* kp = opaque((const v4u*)(F.KB + ((size_t)b * SEQ + key) * D + h * HD));
                float s = 0.f;
#pragma unroll
                for (int c = 0; c < 8; ++c) { const v4u w = kp[c]; s += bflo(qp[4 * c + 0]) * bflo(w.x) + bfhi(qp[4 * c + 0]) * bfhi(w.x) + bflo(qp[4 * c + 1]) * bflo(w.y) + bfhi(qp[4 * c + 1]) * bfhi(w.y)
                    + bflo(qp[4 * c + 2]) * bflo(w.z) + bfhi(qp[4 * c + 2]) * bfhi(w.z) + bflo(qp[4 * c + 3]) * bflo(w.w) + bfhi(qp[4 * c + 3]) * bfhi(w.w); }
                asm volatile("" : "+v"(s));
                const bool ok = use && (key <= q);
                const float mn = ok ? fmaxf(mx, s) : mx;
                const float a = (mn == mx) ? 1.0f : __builtin_amdgcn_exp2f(mx - mn);
                const float p = ok ? __builtin_amdgcn_exp2f(s - mn) : 0.f;
                l = l * a + p; mx = mn;
                const v4u* vp = opaque((const v4u*)(F.VB + ((size_t)b * SEQ + key) * D + h * HD));
#pragma unroll
                for (int c = 0; c < 8; ++c) { const v4u w = vp[c];
                    o[8 * c + 0] = o[8 * c + 0] * a + p * bflo(w.x); o[8 * c + 1] = o[8 * c + 1] * a + p * bfhi(w.x); o[8 * c + 2] = o[8 * c + 2] * a + p * bflo(w.y); o[8 * c + 3] = o[8 * c + 3] * a + p * bfhi(w.y);
                    o[8 * c + 4] = o[8 * c + 4] * a + p * bflo(w.z); o[8 * c + 5] = o[8 * c + 5] * a + p * bfhi(w.z); o[8 * c + 6] = o[8 * c + 6] * a + p * bflo(w.w); o[8 * c + 7] = o[8 * c + 7] * a + p * bfhi(w.w); }
            }
        }
        const float rl = 1.0f / l;
        GAS v4u* op = (GAS v4u*)(F.QO + rowq * D + h * HD);
#pragma unroll
        for (int c = 0; c < 8; ++c) { v4u w; w.x = pk2(o[8 * c + 0] * rl, o[8 * c + 1] * rl); w.y = pk2(o[8 * c + 2] * rl, o[8 * c + 3] * rl); w.z = pk2(o[8 * c + 4] * rl, o[8 * c + 5] * rl); w.w = pk2(o[8 * c + 6] * rl, o[8 * c + 7] * rl); op[c] = w; }
    }
}

__device__ __forceinline__ void resln_phase(Frame& F, const bf16* Hout, const float* g, const float* bta) {
    const int gw = F.vcu * NWAVES + F.wave, NGW = F.G * NWAVES;
    for (int row = gw; row < M; row += NGW) {
        float v[16];
#pragma unroll
        for (int hf = 0; hf < 2; ++hf) { const v4u x = *(const v4u*)(F.XN + (size_t)row * D + hf * 512 + F.lane * 8), y = *(const v4u*)(Hout + (size_t)row * D + hf * 512 + F.lane * 8);
            v[8 * hf + 0] = ALPHA * bflo(x.x) + bflo(y.x); v[8 * hf + 1] = ALPHA * bfhi(x.x) + bfhi(y.x); v[8 * hf + 2] = ALPHA * bflo(x.y) + bflo(y.y); v[8 * hf + 3] = ALPHA * bfhi(x.y) + bfhi(y.y);
            v[8 * hf + 4] = ALPHA * bflo(x.z) + bflo(y.z); v[8 * hf + 5] = ALPHA * bfhi(x.z) + bfhi(y.z); v[8 * hf + 6] = ALPHA * bflo(x.w) + bflo(y.w); v[8 * hf + 7] = ALPHA * bfhi(x.w) + bfhi(y.w); }
        float s = 0.f;
#pragma unroll
        for (int i = 0; i < 16; ++i) s += v[i];
        const float mean = wave_sum(s) * (1.f / D); float s2 = 0.f;
#pragma unroll
        for (int i = 0; i < 16; ++i) { v[i] -= mean; s2 += v[i] * v[i]; }
        const float rstd = 1.f / sqrtf(wave_sum(s2) * (1.f / D) + LN_EPS);
#pragma unroll
        for (int hf = 0; hf < 2; ++hf) { const int c0 = hf * 512 + F.lane * 8; const f32x4 g0 = *(const f32x4*)(g + c0), g1 = *(const f32x4*)(g + c0 + 4), b0 = *(const f32x4*)(bta + c0), b1 = *(const f32x4*)(bta + c0 + 4);
            v4u o; o.x = pk2(v[8 * hf + 0] * rstd * g0[0] + b0[0], v[8 * hf + 1] * rstd * g0[1] + b0[1]); o.y = pk2(v[8 * hf + 2] * rstd * g0[2] + b0[2], v[8 * hf + 3] * rstd * g0[3] + b0[3]);
            o.z = pk2(v[8 * hf + 4] * rstd * g1[0] + b1[0], v[8 * hf + 5] * rstd * g1[1] + b1[1]); o.w = pk2(v[8 * hf + 6] * rstd * g1[2] + b1[2], v[8 * hf + 7] * rstd * g1[3] + b1[3]);
            *(GAS v4u*)(F.XN + (size_t)row * D + c0) = o; }
    }
}

__device__ __forceinline__ void router_phase(Frame& F, const Args& A, int l) {
    const int rg = F.wave & 3, kh = F.wave >> 2, fr = F.lane & 15, fq = F.lane >> 4;
    const bf16* Wr = (const bf16*)(F.ws + WS_WR) + (size_t)l * 2 * NRT * D;
    LAS float* part = (LAS float*)(F.lds + RING_OFF);
    int* tok = (int*)(F.ws + WS_TOK); int* asg = (int*)(F.ws + WS_ASG); float* gate = (float*)(F.ws + WS_ASG + 128 * 1024);
    for (int rb = F.vcu; rb < M / 64; rb += F.G) {
        const int row0 = rb * 64;
        const bf16* ap = F.XN + (size_t)(row0 + rg * 16 + fr) * D + kh * 512 + fq * 8;
        const bf16* bp = Wr + (size_t)fr * D + kh * 512 + fq * 8;
        f32x4 acc[5];
#pragma unroll
        for (int nf = 0; nf < 5; ++nf) acc[nf] = (f32x4){0.f, 0.f, 0.f, 0.f};
#pragma unroll 1
        for (int ks = 0; ks < 16; ++ks) {
            const bf16x8 a = *(const bf16x8*)(ap + ks * 32);
#pragma unroll
            for (int nf = 0; nf < 5; ++nf) {
                const bf16x8 bh = *(const bf16x8*)(bp + (size_t)nf * 16 * D + ks * 32), bl = *(const bf16x8*)(bp + (size_t)(NRT + nf * 16) * D + ks * 32);
                acc[nf] = __builtin_amdgcn_mfma_f32_16x16x32_bf16(a, bh, acc[nf], 0, 0, 0);
                acc[nf] = __builtin_amdgcn_mfma_f32_16x16x32_bf16(a, bl, acc[nf], 0, 0, 0);
            }
        }
#pragma unroll
        for (int nf = 0; nf < 5; ++nf)
#pragma unroll
            for (int j = 0; j < 4; ++j) part[(kh * 64 + rg * 16 + fq * 4 + j) * NRT + nf * 16 + fr] = acc[nf][j];
        __syncthreads();
        if (F.tid < 64) {
            const int t = F.tid, token = row0 + t;
            const LAS float* p0 = part + t * NRT; const LAS float* p1 = part + (64 + t) * NRT;
            float gl[8]; float gmax = -INFINITY; int gi = 0;
#pragma unroll
            for (int j = 0; j < 8; ++j) { gl[j] = p0[j] + p1[j] + A.in[15][l * 8 + j]; if (gl[j] > gmax) { gmax = gl[j]; gi = j; } }
            float gs = 0.f;
#pragma unroll
            for (int j = 0; j < 8; ++j) gs += __expf(gl[j] - gmax);
            const float gp = 1.0f / gs;
            float v0 = -INFINITY, v1 = -INFINITY; int i0 = 0, i1 = 0;
#pragma unroll
            for (int j = 0; j < 8; ++j) { const float e = p0[8 + gi * 8 + j] + p1[8 + gi * 8 + j] + A.in[17][l * NE + gi * 8 + j];
                if (e > v0) { v1 = v0; i1 = i0; v0 = e; i0 = j; } else if (e > v1) { v1 = e; i1 = j; } }
            const float pa = 1.0f / (1.0f + __expf(v1 - v0)), pb = 1.0f - pa;
            const int e0 = gi * 8 + i0, e1 = gi * 8 + i1;
            const unsigned q0 = __hip_atomic_fetch_add((unsigned*)(F.ctl + CW_CNT + l * NE + e0), 1u, RLX_AGENT);
            const unsigned q1 = __hip_atomic_fetch_add((unsigned*)(F.ctl + CW_CNT + l * NE + e1), 1u, RLX_AGENT);
            tok[e0 * TOKCAP + q0] = token; tok[e1 * TOKCAP + q1] = token;
            asg[token * 2 + 0] = (e0 << 16) | (int)q0; asg[token * 2 + 1] = (e1 << 16) | (int)q1;
            gate[token * 2 + 0] = gp * pa; gate[token * 2 + 1] = gp * pb;
        }
        __syncthreads();
    }
}

__device__ __forceinline__ int moe_tables(Frame& F, int l) {
    LAS int* cnt = (LAS int*)(F.lds + TAB_OFF); LAS int* tstart = cnt + 64; LAS int* tile_e = cnt + 64 + 68;
    if (F.tid < 64) cnt[F.tid] = (int)__hip_atomic_load(F.ctl + CW_CNT + l * NE + F.tid, RLX_AGENT);
    __syncthreads();
    if (F.tid == 0) { int s = 0; for (int e = 0; e < NE; ++e) { tstart[e] = s; s += (cnt[e] + 255) >> 8; } tstart[NE] = s; }
    __syncthreads();
    const int ntiles = tstart[NE];
    if (F.tid < ntiles && F.tid < 256) { int e = 0; for (int k = 0; k < NE; ++k) if (tstart[k + 1] <= F.tid) e = k + 1; tile_e[F.tid] = e; }
    __syncthreads();
    return ntiles < MAXTILES ? ntiles : MAXTILES;
}
struct MoeOrder {
    int ntiles, npn, G, c; const LAS int* cnt; const LAS int* tstart; const LAS int* tile_e;
    __device__ __forceinline__ bool next(int i, pg8::Unit& u) const {
        const int L = i * G + c; if (L >= ntiles * npn) return false;
        const int tile = L / npn, pn = L % npn, e = tile_e[tile], chunk = tile - tstart[e];
        u.pm = tile; u.pn = pn; u.pb = e * npn + pn; u.gofs = e * TOKCAP + chunk * 256; const int left = cnt[e] - chunk * 256; u.gcnt = left < 256 ? left : 256; return true;
    }
};

__device__ __forceinline__ void combine_phase(Frame& F, int l, const float* g, const float* bta, bool last_layer) {
    const LAS int* tstart = (const LAS int*)(F.lds + TAB_OFF) + 64;
    const int gw = F.vcu * NWAVES + F.wave, NGW = F.G * NWAVES;
    const int* asg = (const int*)(F.ws + WS_ASG); const float* gate = (const float*)(F.ws + WS_ASG + 128 * 1024);
    for (int row = gw; row < M; row += NGW) {
        const int* ap = opaque(asg + row * 2); const float* gp = opaque(gate + row * 2);
        const int a0 = ap[0], a1 = ap[1]; const float g0 = gp[0], g1 = gp[1];
        const size_t r0 = (size_t)tstart[a0 >> 16] * 256 + (a0 & 0xffff), r1 = (size_t)tstart[a1 >> 16] * 256 + (a1 & 0xffff);
        float v[16];
#pragma unroll
        for (int hf = 0; hf < 2; ++hf) { const int c0 = hf * 512 + F.lane * 8;
            const v4u x = *(const v4u*)(F.XN + (size_t)row * D + c0), y = *(const v4u*)(F.YB + r0 * D + c0), z = *(const v4u*)(F.YB + r1 * D + c0);
            v[8 * hf + 0] = ALPHA * bflo(x.x) + g0 * bflo(y.x) + g1 * bflo(z.x); v[8 * hf + 1] = ALPHA * bfhi(x.x) + g0 * bfhi(y.x) + g1 * bfhi(z.x);
            v[8 * hf + 2] = ALPHA * bflo(x.y) + g0 * bflo(y.y) + g1 * bflo(z.y); v[8 * hf + 3] = ALPHA * bfhi(x.y) + g0 * bfhi(y.y) + g1 * bfhi(z.y);
            v[8 * hf + 4] = ALPHA * bflo(x.z) + g0 * bflo(y.z) + g1 * bflo(z.z); v[8 * hf + 5] = ALPHA * bfhi(x.z) + g0 * bfhi(y.z) + g1 * bfhi(z.z);
            v[8 * hf + 6] = ALPHA * bflo(x.w) + g0 * bflo(y.w) + g1 * bflo(z.w); v[8 * hf + 7] = ALPHA * bfhi(x.w) + g0 * bfhi(y.w) + g1 * bfhi(z.w); }
        float s = 0.f;
#pragma unroll
        for (int i = 0; i < 16; ++i) s += v[i];
        const float mean = wave_sum(s) * (1.f / D); float s2 = 0.f;
#pragma unroll
        for (int i = 0; i < 16; ++i) { v[i] -= mean; s2 += v[i] * v[i]; }
        const float rstd = 1.f / sqrtf(wave_sum(s2) * (1.f / D) + LN_EPS);
#pragma unroll
        for (int hf = 0; hf < 2; ++hf) { const int c0 = hf * 512 + F.lane * 8; const f32x4 g0v = *(const f32x4*)(g + c0), g1v = *(const f32x4*)(g + c0 + 4), b0 = *(const f32x4*)(bta + c0), b1 = *(const f32x4*)(bta + c0 + 4);
            float o[8];
#pragma unroll
            for (int i = 0; i < 4; ++i) { o[i] = v[8 * hf + i] * rstd * g0v[i] + b0[i]; o[4 + i] = v[8 * hf + 4 + i] * rstd * g1v[i] + b1[i]; }
            if (last_layer) { GAS f32x4* op = (GAS f32x4*)(F.out + (size_t)row * D + c0); op[0] = (f32x4){o[0], o[1], o[2], o[3]}; op[1] = (f32x4){o[4], o[5], o[6], o[7]}; }
            else { v4u w; w.x = pk2(o[0], o[1]); w.y = pk2(o[2], o[3]); w.z = pk2(o[4], o[5]); w.w = pk2(o[6], o[7]); *(GAS v4u*)(F.XN + (size_t)row * D + c0) = w; } }
    }
}

__device__ __forceinline__ void g2a_phase(Frame& F) {
    typedef float f32x2v __attribute__((ext_vector_type(2)));
    const int gt = F.vcu * (NWAVES * 64) + F.tid, NGT = F.G * NWAVES * 64;
    const f32x2v* vp = (const f32x2v*)(F.ws + WS_VPART); f32x2v* vs = (f32x2v*)(F.ws + WS_ASG + 256 * 1024);
    for (int row = gt; row < M; row += NGT) { float s1 = 0.f, s2 = 0.f;
        for (int i = 0; i < 48; ++i) { const f32x2v p = vp[(size_t)row * 48 + i]; s1 += p.x; s2 += p.y; }
        const float mean = s1 * (1.f / DV), var = s2 * (1.f / DV) - mean * mean;
        vs[row] = (f32x2v){mean, 1.f / sqrtf(fmaxf(var, 0.f) + LN_EPS)}; }
}
__device__ __forceinline__ void g2b_naive_phase(Frame& F, const Args& A, int j) {
    typedef float f32x2v __attribute__((ext_vector_type(2)));
    const int gt = F.vcu * (NWAVES * 64) + F.tid, NGT = F.G * NWAVES * 64;
    const f32x2v* vs = (const f32x2v*)(F.ws + WS_ASG + 256 * 1024);
    const float* lg = A.in[5] + (size_t)j * DV; const float* lb = A.in[6] + (size_t)j * DV;
    const float* Ws = A.in[7] + (size_t)j * GG * CHK * CHK; const float* bs = A.in[8] + (size_t)j * GG * CHK;
    for (int id = gt; id < M * (DV / 8); id += NGT) {
        const int row = id / (DV / 8), k0 = (id % (DV / 8)) * 8, g = k0 / GD, t = row & (CHK - 1), r0 = row - t;
        float gk[8], bk[8], acc[8];
#pragma unroll
        for (int i = 0; i < 8; ++i) { gk[i] = lg[k0 + i]; bk[i] = lb[k0 + i]; acc[i] = 0.f; }
        const float* wrow = Ws + ((size_t)g * CHK + t) * CHK;
        for (int s = 0; s <= t; ++s) {
            const float w = wrow[s]; const f32x2v st = vs[r0 + s];
            const v4u vv = *(const v4u*)(F.VVB + (size_t)(r0 + s) * DV + k0);
            const float ws_ = w * st.y;
            acc[0] += ws_ * (bflo(vv.x) - st.x) * gk[0] + w * bk[0]; acc[1] += ws_ * (bfhi(vv.x) - st.x) * gk[1] + w * bk[1];
            acc[2] += ws_ * (bflo(vv.y) - st.x) * gk[2] + w * bk[2]; acc[3] += ws_ * (bfhi(vv.y) - st.x) * gk[3] + w * bk[3];
            acc[4] += ws_ * (bflo(vv.z) - st.x) * gk[4] + w * bk[4]; acc[5] += ws_ * (bfhi(vv.z) - st.x) * gk[5] + w * bk[5];
            acc[6] += ws_ * (bflo(vv.w) - st.x) * gk[6] + w * bk[6]; acc[7] += ws_ * (bfhi(vv.w) - st.x) * gk[7] + w * bk[7];
        }
        const float bt = bs[g * CHK + t];
        const v4u uu = *(const v4u*)(F.UB + (size_t)row * DV + k0);
        v4u o; o.x = pk2(bflo(uu.x) * (acc[0] + bt), bfhi(uu.x) * (acc[1] + bt)); o.y = pk2(bflo(uu.y) * (acc[2] + bt), bfhi(uu.y) * (acc[3] + bt));
        o.z = pk2(bflo(uu.z) * (acc[4] + bt), bfhi(uu.z) * (acc[5] + bt)); o.w = pk2(bflo(uu.w) * (acc[6] + bt), bfhi(uu.w) * (acc[7] + bt));
        *(GAS v4u*)(F.UB + (size_t)row * DV + k0) = o;
    }
}

constexpr int NPHASES = 1 + 2 * 8 + 2 * 9;
#ifndef MK_N_LAUNCHES
#define MK_N_LAUNCHES NPHASES
#endif
#ifndef PG8_SP2
#define PG8_SP2 false
#endif
#ifndef DBG_QKV
#define DBG_QKV(...) __VA_ARGS__
#endif
#ifndef DBG_G1
#define DBG_G1(...) __VA_ARGS__
#endif
#ifndef DBG_WO
#define DBG_WO(...) __VA_ARGS__
#endif
#ifndef DBG_M1
#define DBG_M1(...) __VA_ARGS__
#endif
#ifndef DBG_M2
#define DBG_M2(...) __VA_ARGS__
#endif
#ifndef DBG_ATTN
#define DBG_ATTN(x) x
#endif
#ifndef DBG_G2B
#define DBG_G2B(x) x
#endif
#ifndef DBG_RT
#define DBG_RT(x) x
#endif
#ifndef DBG_P0
#define DBG_P0(x) x
#endif
#define MKFRAME() \
        unsigned char* ws; \
        { unsigned long long w = (unsigned long long)args.ws; unsigned wl = (unsigned)w, wh = (unsigned)(w >> 32); \
          asm volatile("" : "+v"(wl), "+v"(wh)); \
          wl = __builtin_amdgcn_readfirstlane(wl); wh = __builtin_amdgcn_readfirstlane(wh); \
          ws = (unsigned char*)(((unsigned long long)wh << 32) | wl); } \
        int tid_ = threadIdx.x; asm volatile("" : "+v"(tid_)); \
        Frame F; \
        F.lds = (LAS unsigned char*)lds; \
        F.MISC = (volatile LAS unsigned*)(F.lds + MISC_OFF); \
        F.tid = tid_; F.lane = F.tid & 63; F.wave = __builtin_amdgcn_readfirstlane(F.tid >> 6); \
        F.G = gridDim.x; { const int bx = blockIdx.x; F.vcu = (F.G % 8 == 0) ? (bx % 8) * (F.G / 8) + bx / 8 : bx; } \
        F.ws = ws; F.out = args.out; \
        F.ctl = (gu32*)(ws + WS_CTL); \
        F.XN = (bf16*)(ws + WS_XN); F.QO = (bf16*)(ws + WS_QO); F.KB = (bf16*)(ws + WS_K); F.VB = (bf16*)(ws + WS_V); F.UB = (bf16*)(ws + WS_U); F.VVB = (bf16*)(ws + WS_VV); \
        F.HB = (bf16*)(ws + WS_HB); F.YB = (bf16*)(ws + WS_YB);
__global__ void __launch_bounds__(NWAVES * 64, 2) fwd_kernel(Args args) {
    extern __shared__ __attribute__((aligned(16))) unsigned char lds[];
    for (int u = threadIdx.x; u < (LDS_BYTES - LDSCTL_OFF) / 4; u += NWAVES * 64) ((LAS unsigned*)((LAS unsigned char*)lds + LDSCTL_OFF))[u] = 0u;
    __syncthreads();
    const int lo = args.ph_lo, hi = args.ph_hi;
    XcdBarrier bar; bar.bar = (unsigned*)(args.ws + WS_CTL) + CW_BAR; bar.x = 0; bar.st = nullptr;
    if (hi - lo > 1) bar = xcd_barrier_post((unsigned*)(args.ws + WS_CTL) + CW_BAR, (volatile LAS unsigned*)((LAS unsigned char*)lds + MISC_OFF) + 8);
    for (int pk = lo; pk < hi; ++pk) {
        int kind = 0, l = 0;
        if (pk > 0) { const int p = pk - 1, pair = p / 17, r = p % 17;
            if (r < 8) { l = 2 * pair; kind = (r == 0) ? 1 : (r == 1) ? 2 : r + 4; }
            else { l = 2 * pair + 1; kind = (r - 8) + 3; } }
        const int j = l >> 1;
        if (kind == 0) { MKFRAME(); DBG_P0(p0_prologue(F, args)); }
        else if (kind == 1) { MKFRAME(); pg8::Gemm g{F.XN, (const bf16*)(ws + WS_WQKV) + (size_t)j * NQKV * D, M, NQKV, D, nullptr}; pg8::StaticOrder S; S.init(M, NQKV, F.G, (int)blockIdx.x);
            pg8::EpiBf16<0, 1> E{F.QO, D, nullptr, D, (size_t)(WS_K - WS_QO) / 2, QSCALE, (float*)(ws + WS_KSUM)};
            DBG_QKV(pg8::gemm_phase<pg8::EpiBf16<0, 1>, pg8::StaticOrder, true, PG8_SP2, false>(F.lds + RING_OFF, g, S, E, F.tid)); }
        else if (kind == 2) { MKFRAME(); DBG_ATTN(attn_naive_phase(F)); }
        else if (kind == 3) { MKFRAME(); pg8::Gemm g{F.XN, (const bf16*)(ws + WS_WIN) + (size_t)j * NZ * D, M, NZ, D, nullptr}; pg8::StaticOrder S; S.init(M, NZ, F.G, (int)blockIdx.x);
            pg8::EpiBf16<1, 2> E{F.UB, DV, args.in[4] + (size_t)j * NZ, DV, (size_t)(WS_VV - WS_U) / 2, 1.0f, (float*)(ws + WS_VPART)};
            DBG_G1(pg8::gemm_phase<pg8::EpiBf16<1, 2>, pg8::StaticOrder, true, PG8_SP2, false>(F.lds + RING_OFF, g, S, E, F.tid)); }
        else if (kind == 4) { MKFRAME(); g2a_phase(F); }
        else if (kind == 5) { MKFRAME(); DBG_G2B(g2b_naive_phase(F, args, j)); }
        else if (kind == 6) { MKFRAME(); pg8::Gemm g; if ((l & 1) == 0) g = pg8::Gemm{F.QO, (const bf16*)(ws + WS_WO) + (size_t)j * D * D, M, D, D, nullptr}; else g = pg8::Gemm{F.UB, (const bf16*)(ws + WS_WOUT) + (size_t)j * D * DV, M, D, DV, nullptr};
            pg8::StaticOrder S; S.init(M, D, F.G, (int)blockIdx.x);
            pg8::EpiBf16<0, 0> E{F.YB, D, nullptr, 0, 0, 1.0f, nullptr};
            DBG_WO(pg8::gemm_phase<pg8::EpiBf16<0, 0>, pg8::StaticOrder, true, PG8_SP2, false>(F.lds + RING_OFF, g, S, E, F.tid)); }
        else if (kind == 7) { MKFRAME(); resln_phase(F, F.YB, args.in[10] + (size_t)l * D, args.in[11] + (size_t)l * D); }
        else if (kind == 8) { MKFRAME(); DBG_RT(router_phase(F, args, l)); }
        else if (kind == 9) { MKFRAME(); const int ntiles = moe_tables(F, l); const LAS int* tb = (const LAS int*)(F.lds + TAB_OFF);
            pg8::Gemm g{F.XN, (const bf16*)(ws + WS_W13) + (size_t)l * NE * 512 * D, M, 512, D, (const int*)(ws + WS_TOK)};
            MoeOrder S{ntiles, 2, F.G, F.vcu, tb, tb + 64, tb + 64 + 68};
            pg8::EpiMoe1 E{F.HB};
            DBG_M1(pg8::gemm_phase<pg8::EpiMoe1, MoeOrder, true, PG8_SP2, true>(F.lds + RING_OFF, g, S, E, F.tid)); }
        else if (kind == 10) { MKFRAME(); const int ntiles = moe_tables(F, l); const LAS int* tb = (const LAS int*)(F.lds + TAB_OFF);
            pg8::Gemm g{F.HB, (const bf16*)(ws + WS_W2) + (size_t)l * NE * D * FE, MAXTILES * 256, D, FE, nullptr};
            MoeOrder S{ntiles, 4, F.G, F.vcu, tb, tb + 64, tb + 64 + 68};
            pg8::EpiBf16<0, 0> E{F.YB, D, nullptr, 0, 0, 1.0f, nullptr};
            DBG_M2(pg8::gemm_phase<pg8::EpiBf16<0, 0>, MoeOrder, true, PG8_SP2, false>(F.lds + RING_OFF, g, S, E, F.tid)); }
        else { MKFRAME(); (void)moe_tables(F, l); combine_phase(F, l, args.in[12] + (size_t)l * D, args.in[13] + (size_t)l * D, l == DEPTH - 1); }
        if (pk + 1 < hi) xcd_barrier(bar);
    }
}

extern "C" void kernel_launch(void* const* d_in, const int* in_sizes, int n_in, void* d_out, int out_size, void* d_ws, size_t ws_size, hipStream_t stream) {
    static int grid = 0;
    if (grid == 0) {
        if (n_in != 21 || in_sizes[0] != M * D || out_size != M * D || ws_size < WS_END) { fprintf(stderr, "kernel_launch: unexpected shapes (n_in %d, in0 %d, out %d, ws %zu); nothing launched\n", n_in, n_in > 0 ? in_sizes[0] : -1, out_size, ws_size); grid = -1; return; }
        int dev = 0, cus = 0, per_cu = 0;
        if (hipGetDevice(&dev) != hipSuccess || hipDeviceGetAttribute(&cus, hipDeviceAttributeMultiprocessorCount, dev) != hipSuccess) { fprintf(stderr, "kernel_launch: device query failed\n"); grid = -1; return; }
        if (hipFuncSetAttribute((const void*)fwd_kernel, hipFuncAttributeMaxDynamicSharedMemorySize, LDS_BYTES) != hipSuccess) { fprintf(stderr, "kernel_launch: hipFuncSetAttribute failed\n"); grid = -1; return; }
        if (hipOccupancyMaxActiveBlocksPerMultiprocessor(&per_cu, (const void*)fwd_kernel, NWAVES * 64, LDS_BYTES) != hipSuccess || per_cu < 1)
            fprintf(stderr, "kernel_launch: note: occupancy query reports %d workgroups per CU\n", per_cu);
        (void)hipGetLastError();
        grid = cus;
        if (grid != 256) fprintf(stderr, "kernel_launch: %d CUs; this build expects 256\n", grid);
    }
    if (grid < 0) return;
    if (hipMemsetAsync((char*)d_ws + WS_CTL, 0, CTL_ZERO_BYTES, stream) != hipSuccess) { fprintf(stderr, "kernel_launch: hipMemsetAsync failed\n"); return; }
    Args a{};
    for (int i = 0; i < 21; ++i) a.in[i] = (const float*)d_in[i];
    a.out = (float*)d_out; a.ws = (unsigned char*)d_ws;
    constexpr int NL = MK_N_LAUNCHES;
    for (int li = 0; li < NL; ++li) {
        if (NL == 1) { a.ph_lo = 0; a.ph_hi = NPHASES; } else { a.ph_lo = li; a.ph_hi = li + 1; }
        hipLaunchKernelGGL(fwd_kernel, dim3(grid), dim3(NWAVES * 64), LDS_BYTES, stream, a);
        const hipError_t le = hipPeekAtLastError();
        if (le != hipSuccess) { fprintf(stderr, "kernel_launch: launch %d failed: %s\n", li, hipGetErrorName(le)); break; }
    }
}
```

```cpp
#include <hip/hip_runtime.h>
#include <hip/hip_bf16.h>
#include <cstdio>
#include <cstdint>
#include <cmath>
namespace pg8 {
#define PG8_LAS __attribute__((address_space(3)))
typedef unsigned short bf16_t;
typedef short bf16x8 __attribute__((ext_vector_type(8)));
typedef float f32x4 __attribute__((ext_vector_type(4)));
typedef unsigned u32x4 __attribute__((ext_vector_type(4)));
typedef unsigned u32x2 __attribute__((ext_vector_type(2)));
constexpr int BM = 256, BK = 64, HALF = 128, HTB = HALF * BK * 2  , STAGE_BYTES = 8 * HTB, NXCD = 8, WGM = 8;

__host__ __device__ __forceinline__ int lds_byte(int r, int c) { const int st = (r >> 4) * 2 + (c >> 5), rr = r & 15, cc = c & 31, ob = rr * 64 + cc * 2; return st * 1024 + (ob ^ (((ob >> 9) & 1) << 5)); }
__host__ __device__ __forceinline__ void stage_rc(int b, int& R, int& C) { const int st = b / 1024, sb = b % 1024, swz = sb ^ (((sb >> 9) & 1) << 5); R = (st >> 1) * 16 + swz / 64; C = (st & 1) * 32 + (swz % 64) / 2; }
__host__ __device__ __forceinline__ int perm32(int rho) { const int n = rho >> 4, i = rho & 15; return 8 * (i >> 2) + 4 * n + (i & 3); }

struct Unit { int pm, pn, pb, gofs, gcnt; };
struct Gemm { const bf16_t* A; const bf16_t* Bt; int M, N, K; const int* rows; };

struct StaticOrder {
    int nM, nN, nwg, G, c;
    __host__ __device__ void init(int M, int N, int G_, int c_) { nM = M / BM; nN = N / BM; nwg = nM * nN; G = G_; c = c_; }
    __host__ __device__ bool next(int i, Unit& u) const {
        const long L = (long)i * G + c; if (L >= nwg) return false;
        int wgid = (int)L; { const int q = nwg / NXCD, r = nwg % NXCD, xcd = wgid % NXCD, off = wgid / NXCD; wgid = (xcd < r ? xcd * (q + 1) : r * (q + 1) + (xcd - r) * q) + off; }
        const int nig = WGM * nN, gid = wgid / nig, fm = gid * WGM, gsz = (nM - fm) < WGM ? (nM - fm) : WGM;
        u.pm = fm + ((wgid % nig) % gsz); u.pn = (wgid % nig) / gsz; u.pb = u.pn; u.gofs = 0; u.gcnt = 0; return true;
    }
};

__device__ __forceinline__ unsigned cvt_pk_bf16(float lo, float hi) { unsigned r; asm volatile("v_cvt_pk_bf16_f32 %0, %1, %2" : "=v"(r) : "v"(lo), "v"(hi)); return r; }
typedef float f32x2 __attribute__((ext_vector_type(2)));
__device__ __forceinline__ f32x2 gelu_pk(f32x2 v) {
    const f32x2 av = __builtin_elementwise_abs(v), d = av * 0.2316418882f + 1.0f;
    f32x2 t; t.x = __builtin_amdgcn_rcpf(d.x); t.y = __builtin_amdgcn_rcpf(d.y);
    f32x2 q = t * 0.5307027145f + (-0.7265760135f); q = q * t + 0.7107068705f; q = q * t + (-0.142248368f); q = q * t + 0.127414796f; q = q * t;
    const f32x2 s = (v * v) * (-0.72134752044f);
    f32x2 e; e.x = __builtin_amdgcn_exp2f(s.x); e.y = __builtin_amdgcn_exp2f(s.y);
    const f32x2 m = v * (q * e), r = v - m;
    f32x2 o; o.x = v.x < 0.f ? m.x : r.x; o.y = v.y < 0.f ? m.y : r.y; return o;
}

template <int ACT, int EXTRA> struct EpiBf16 {
    static constexpr bool PERM = true, AFTER_DRAIN = false; static_assert(ACT == 0 || ACT == 1, "EpiBf16: ACT is 0 (none) or 1 (gelu_pk)");
    bf16_t* O; int ldc; const float* bias; int split_cols; size_t split_stride; float scale0; float* xtra;
    __device__ __forceinline__ void operator()(const f32x4 (&acc)[2][2][4][2], const Unit& u, int wr, int wc, int fr, int fq) const {
        const int row0 = u.pm * BM + wr * 64 + fr; int colt = u.pn * BM; bf16_t* base = O;
        float sc = 1.f; if (split_cols) { const int t = colt / split_cols; base += (size_t)t * split_stride; colt -= t * split_cols; if (t == 0) sc = scale0; }
        const int col0 = colt + wc * 32 + 8 * fq, bcol0 = u.pn * BM + wc * 32 + 8 * fq;
        f32x4 bv[2][2];
#pragma unroll
        for (int bj = 0; bj < 2; ++bj)
#pragma unroll
            for (int n = 0; n < 2; ++n) bv[bj][n] = bias ? *(const f32x4*)(bias + bcol0 + bj * HALF + 4 * n) : (f32x4){0.f, 0.f, 0.f, 0.f};
        f32x4 cs[2][2];
        if (EXTRA == 1) {
#pragma unroll
            for (int bj = 0; bj < 2; ++bj)
#pragma unroll
                for (int n = 0; n < 2; ++n) cs[bj][n] = (f32x4){0.f, 0.f, 0.f, 0.f};
        }
        const bool vt = (EXTRA == 2) && (u.pn >= 12);
#pragma unroll
        for (int ai = 0; ai < 2; ++ai)
#pragma unroll
            for (int m = 0; m < 4; ++m) { bf16_t* rowp = base + (size_t)(row0 + ai * HALF + m * 16) * ldc + col0;
                float s1 = 0.f, s2 = 0.f;
#pragma unroll
                for (int bj = 0; bj < 2; ++bj) { f32x4 v0 = acc[ai][bj][m][0] + bv[bj][0], v1 = acc[ai][bj][m][1] + bv[bj][1];
                    if (ACT == 1) { f32x2 a = gelu_pk((f32x2){v0[0], v0[1]}), b = gelu_pk((f32x2){v0[2], v0[3]}), c = gelu_pk((f32x2){v1[0], v1[1]}), d = gelu_pk((f32x2){v1[2], v1[3]});
                        v0 = (f32x4){a.x, a.y, b.x, b.y}; v1 = (f32x4){c.x, c.y, d.x, d.y}; }
                    if (EXTRA == 1) { cs[bj][0] += v0; cs[bj][1] += v1; }
                    if (EXTRA == 2) { s1 += ((v0[0] + v0[1]) + (v0[2] + v0[3])) + ((v1[0] + v1[1]) + (v1[2] + v1[3]));
                                      s2 += ((v0[0] * v0[0] + v0[1] * v0[1]) + (v0[2] * v0[2] + v0[3] * v0[3])) + ((v1[0] * v1[0] + v1[1] * v1[1]) + (v1[2] * v1[2] + v1[3] * v1[3])); }
                    v0 = v0 * sc; v1 = v1 * sc; u32x4 w; w.x = cvt_pk_bf16(v0[0], v0[1]); w.y = cvt_pk_bf16(v0[2], v0[3]); w.z = cvt_pk_bf16(v1[0], v1[1]); w.w = cvt_pk_bf16(v1[2], v1[3]);
                    *(u32x4*)(rowp + bj * HALF) = w; }
                if (EXTRA == 2) { if (vt) { s1 += __shfl_xor(s1, 16); s1 += __shfl_xor(s1, 32); s2 += __shfl_xor(s2, 16); s2 += __shfl_xor(s2, 32);
                    if (fq == 0) *(f32x2*)(xtra + ((size_t)(row0 + ai * HALF + m * 16) * 48 + (u.pn - 12) * 4 + wc) * 2) = (f32x2){s1, s2}; } }
            }
        if (EXTRA == 1) { if (u.pn >= 4 && u.pn < 8) {
#pragma unroll
            for (int bj = 0; bj < 2; ++bj)
#pragma unroll
                for (int n = 0; n < 2; ++n) { f32x4 s = cs[bj][n];
#pragma unroll
                    for (int o = 1; o < 16; o <<= 1) { s[0] += __shfl_xor(s[0], o); s[1] += __shfl_xor(s[1], o); s[2] += __shfl_xor(s[2], o); s[3] += __shfl_xor(s[3], o); }
                    if (fr == 0) *(f32x4*)(xtra + ((size_t)wr * (16384 / 256) + u.pm) * 1024 + (u.pn - 4) * BM + bj * HALF + wc * 32 + 8 * fq + 4 * n) = s; } } }
    }
};

struct EpiMoe1 {
    static constexpr bool PERM = true, AFTER_DRAIN = false;
    bf16_t* Hb;
    __device__ __forceinline__ void operator()(const f32x4 (&acc)[2][2][4][2], const Unit& u, int wr, int wc, int fr, int fq) const {
        const int row0 = u.pm * BM + wr * 64 + fr, col0 = u.pn * HALF + wc * 32 + 8 * fq;
#pragma unroll
        for (int ai = 0; ai < 2; ++ai)
#pragma unroll
            for (int m = 0; m < 4; ++m) { bf16_t* rowp = Hb + (size_t)(row0 + ai * HALF + m * 16) * 256 + col0; float h[8];
#pragma unroll
                for (int n = 0; n < 2; ++n)
#pragma unroll
                    for (int j = 0; j < 4; ++j) { const float g = acc[ai][0][m][n][j], up = acc[ai][1][m][n][j];
                        h[n * 4 + j] = g * __builtin_amdgcn_rcpf(1.0f + __builtin_amdgcn_exp2f(-1.4426950408889634f * g)) * up; }
                u32x4 w; w.x = cvt_pk_bf16(h[0], h[1]); w.y = cvt_pk_bf16(h[2], h[3]); w.z = cvt_pk_bf16(h[4], h[5]); w.w = cvt_pk_bf16(h[6], h[7]);
                *(u32x4*)rowp = w; }
    }
};

struct PanelStats {
    unsigned* xbuf;
    unsigned* cnt;
    unsigned* tmo;
    int ntn; float eps; unsigned code;
    __device__ __forceinline__ bool run(const f32x4 (&v)[2][2][4][2], const Unit& u, int wr, int wc, int fr, int fq, PG8_LAS unsigned char* lds, int wid, int lane) const {
        typedef float f32x2v __attribute__((ext_vector_type(2)));
        PG8_LAS f32x2v* P = (PG8_LAS f32x2v*)lds;
        PG8_LAS f32x2v* S = (PG8_LAS f32x2v*)(lds + 8192);
        PG8_LAS unsigned* flag = (PG8_LAS unsigned*)(lds + 8192 + 2048);
#pragma unroll
        for (int ai = 0; ai < 2; ++ai)
#pragma unroll
            for (int m = 0; m < 4; ++m) {
                float s = 0.f;
#pragma unroll
                for (int bj = 0; bj < 2; ++bj)
#pragma unroll
                    for (int n = 0; n < 2; ++n) { const f32x4 x = v[ai][bj][m][n]; s += (x[0] + x[1]) + (x[2] + x[3]); }
                s += __shfl_xor(s, 16); s += __shfl_xor(s, 32);
                const float mw = s * (1.0f / 64.0f); float q = 0.f;
#pragma unroll
                for (int bj = 0; bj < 2; ++bj)
#pragma unroll
                    for (int n = 0; n < 2; ++n) { const f32x4 d = v[ai][bj][m][n] - mw; q += (d[0] * d[0] + d[1] * d[1]) + (d[2] * d[2] + d[3] * d[3]); }
                q += __shfl_xor(q, 16); q += __shfl_xor(q, 32);
                if (fq == 0) P[(ai * HALF + wr * 64 + m * 16 + fr) * 4 + wc] = (f32x2v){mw, q};
            }
        asm volatile("s_waitcnt lgkmcnt(0)" ::: "memory"); __builtin_amdgcn_s_barrier(); asm volatile("" ::: "memory");
        const int row = wid * 32 + (lane & 31);
        if (lane < 32) {
            const f32x2v a = P[row * 4 + 0], b = P[row * 4 + 1], c = P[row * 4 + 2], d = P[row * 4 + 3];
            const float mt = (a.x + b.x + c.x + d.x) * 0.25f;
            const float da = a.x - mt, db = b.x - mt, dc = c.x - mt, dd = d.x - mt;
            const float m2 = (a.y + b.y) + (c.y + d.y) + 64.0f * ((da * da + db * db) + (dc * dc + dd * dd));
            unsigned long long* slot = (unsigned long long*)xbuf + ((size_t)(u.pm * BM + row) * 4 + u.pn);
            __hip_atomic_store(slot, ((unsigned long long)__float_as_uint(m2) << 32) | __float_as_uint(mt), __ATOMIC_RELAXED, __HIP_MEMORY_SCOPE_AGENT);
        }
        asm volatile("s_waitcnt vmcnt(0)" ::: "memory");
        if (lane == 0) __hip_atomic_fetch_add(cnt + 64 * u.pm, 1u, __ATOMIC_RELAXED, __HIP_MEMORY_SCOPE_AGENT);
        if (wid == 0) {
            bool dead = false; const unsigned long long t0 = __builtin_amdgcn_s_memrealtime(); const unsigned want = 8u * (unsigned)ntn;
            for (;;) {
                if ((unsigned)__builtin_amdgcn_readfirstlane(__hip_atomic_load(cnt + 64 * u.pm, __ATOMIC_RELAXED, __HIP_MEMORY_SCOPE_AGENT)) >= want) break;
                if (__builtin_amdgcn_s_memrealtime() - t0 > 2000000ull) {
                    if (lane == 0) { unsigned expect = 0u; __hip_atomic_compare_exchange_strong(tmo + 1, &expect, code | (unsigned)(u.pm & 0xff), __ATOMIC_RELAXED, __ATOMIC_RELAXED, __HIP_MEMORY_SCOPE_AGENT);
                                     __hip_atomic_store(tmo, 1u, __ATOMIC_RELAXED, __HIP_MEMORY_SCOPE_AGENT); }
                    dead = true; break; }
                __builtin_amdgcn_s_sleep(2);
            }
            __builtin_amdgcn_fence(__ATOMIC_ACQUIRE, "agent");
            if (lane == 0) flag[0] = dead ? 1u : 0u;
        }
        asm volatile("s_waitcnt vmcnt(0) lgkmcnt(0)" ::: "memory"); __builtin_amdgcn_s_barrier(); asm volatile("" ::: "memory");
        const bool bad = flag[0] != 0u;
        if (lane < 32) {
            const unsigned long long* slot = (const unsigned long long*)xbuf + (size_t)(u.pm * BM + row) * 4; float mt[4], m2[4]; float ms = 0.f;
#pragma unroll
            for (int t = 0; t < 4; ++t) { if (t < ntn) { const unsigned long long w = __hip_atomic_load(slot + t, __ATOMIC_RELAXED, __HIP_MEMORY_SCOPE_AGENT); mt[t] = __uint_as_float((unsigned)w); m2[t] = __uint_as_float((unsigned)(w >> 32)); } else { mt[t] = 0.f; m2[t] = 0.f; } ms += mt[t]; }
            const float mean = ms / (float)ntn; float q = 0.f;
#pragma unroll
            for (int t = 0; t < 4; ++t) if (t < ntn) { const float dm = mt[t] - mean; q += m2[t] + 256.0f * dm * dm; }
            S[row] = (f32x2v){mean, 1.0f / sqrtf(q / (256.0f * (float)ntn) + eps)};
        }
        asm volatile("s_waitcnt lgkmcnt(0)" ::: "memory"); __builtin_amdgcn_s_barrier(); asm volatile("" ::: "memory");
        return bad;
    }
};
struct EpiLn1 {
    static constexpr bool PERM = false, AFTER_DRAIN = true;
    bf16_t* X; const float* gamma; const float* beta; float alpha; PanelStats st;
    __device__ __forceinline__ void fused(f32x4 (&acc)[2][2][4][2], const Unit& u, int wr, int wc, int fr, int fq, PG8_LAS unsigned char* lds, int wid, int lane) const {
        typedef float f32x2v __attribute__((ext_vector_type(2)));
        const PG8_LAS f32x2v* S = (const PG8_LAS f32x2v*)(lds + 8192);
        const int col0 = u.pn * BM + wc * 32 + 4 * fq;
#pragma unroll
        for (int ai = 0; ai < 2; ++ai)
#pragma unroll
            for (int m = 0; m < 4; ++m) { const size_t off = (size_t)(u.pm * BM + ai * HALF + wr * 64 + m * 16 + fr) * 1024 + col0;
#pragma unroll
                for (int bj = 0; bj < 2; ++bj)
#pragma unroll
                    for (int n = 0; n < 2; ++n) { const u32x2 b = *(const u32x2*)(X + off + bj * HALF + n * 16);
                        const f32x4 bs = (f32x4){__uint_as_float(b.x << 16), __uint_as_float(b.x & 0xffff0000u), __uint_as_float(b.y << 16), __uint_as_float(b.y & 0xffff0000u)};
                        acc[ai][bj][m][n] += bs * alpha; }
                if (m & 1) asm volatile("" ::: "memory"); }
        (void)st.run(acc, u, wr, wc, fr, fq, lds, wid, lane);
        f32x4 gv[2][2], bv[2][2];
#pragma unroll
        for (int bj = 0; bj < 2; ++bj)
#pragma unroll
            for (int n = 0; n < 2; ++n) { gv[bj][n] = *(const f32x4*)(gamma + col0 + bj * HALF + n * 16); bv[bj][n] = *(const f32x4*)(beta + col0 + bj * HALF + n * 16); }
#pragma unroll
        for (int ai = 0; ai < 2; ++ai)
#pragma unroll
            for (int m = 0; m < 4; ++m) { const int r = ai * HALF + wr * 64 + m * 16 + fr; const f32x2v sr = S[r]; const size_t off = (size_t)(u.pm * BM + r) * 1024 + col0;
#pragma unroll
                for (int bj = 0; bj < 2; ++bj)
#pragma unroll
                    for (int n = 0; n < 2; ++n) { const f32x4 o = (acc[ai][bj][m][n] - sr.x) * sr.y * gv[bj][n] + bv[bj][n];
                        u32x2 w; w.x = cvt_pk_bf16(o[0], o[1]); w.y = cvt_pk_bf16(o[2], o[3]); *(u32x2*)(X + off + bj * HALF + n * 16) = w; } }
    }
};

template <class Epi, class Sched, bool ALIGN_EPI = false, bool SP2 = false, bool GATHER = false>
__device__ __forceinline__ void gemm_phase(PG8_LAS unsigned char* lds, const Gemm g, const Sched& S, const Epi& E, const int tid) {
    const int wid = __builtin_amdgcn_readfirstlane(tid >> 6), lane = tid & 63, wr = wid >> 2, wc = wid & 3, fr = lane & 15, fq = lane >> 4;
    const int K = g.K, nt = K / BK;
    unsigned voffA[2], voffB[2]; int gR[2], gC[2];
#pragma unroll
    for (int i = 0; i < 2; ++i) { int R, C; stage_rc(tid * 16 + i * 8192, R, C); const int Rb = Epi::PERM ? ((R & ~31) + perm32(R & 31)) : R;
        voffA[i] = (unsigned)(R * K + C) * 2u; voffB[i] = (unsigned)(Rb * K + C) * 2u; gR[i] = R; gC[i] = C; }
    const size_t kstep = (size_t)(BK * 2);
    const size_t hstep = (size_t)HALF * K * 2;
    const size_t tstep = 2 * hstep;
    const unsigned ldsw = (unsigned)wid * 1024u;
    const int aoff = lds_byte(wr * 64 + fr, fq * 8), boff = lds_byte(wc * 32 + fr, fq * 8);
    unsigned voA[2][2], voAn[2][2];
#define PG8_GOFF(vo, uu) do { if constexpr (GATHER) { _Pragma("unroll") for (int _h = 0; _h < 2; ++_h) _Pragma("unroll") for (int _i = 0; _i < 2; ++_i) { \
        const int _r = _h * HALF + gR[_i]; int _tk = 0; if (_r < (uu).gcnt) _tk = g.rows[(uu).gofs + _r]; (vo)[_h][_i] = (unsigned)(_tk * K + gC[_i]) * 2u; } } } while (0)
#define PG8_SA(b, h) (((b) * 2 + (h)) * HTB)
#define PG8_SB(b, h) ((4 + (b) * 2 + (h)) * HTB)
#define PG8_STAGE(bufoff, gbase, voff) do { _Pragma("unroll") for (int _i = 0; _i < 2; ++_i) \
        __builtin_amdgcn_global_load_lds((const unsigned*)((const char*)(gbase) + (voff)[_i]), (PG8_LAS unsigned*)(lds + (bufoff) + ldsw + _i * 8192), 16, 0, 0); } while (0)
#define PG8_STA(b, h, kp, NX) do { if constexpr (GATHER) { unsigned _o[2]; _o[0] = (NX) ? voAn[h][0] : voA[h][0]; _o[1] = (NX) ? voAn[h][1] : voA[h][1]; PG8_STAGE(PG8_SA(b, h), (kp), _o); } \
        else { PG8_STAGE(PG8_SA(b, h), (kp) + (h) * hstep, voffA); } } while (0)
#define PG8_LDA(dst, b, h) do { _Pragma("unroll") for (int m = 0; m < 4; ++m) _Pragma("unroll") for (int k = 0; k < 2; ++k) dst[m][k] = *(const PG8_LAS bf16x8*)(lds + PG8_SA(b, h) + aoff + m * 2048 + k * 1024); } while (0)
#define PG8_LDB(dst, b, h) do { _Pragma("unroll") for (int n = 0; n < 2; ++n) _Pragma("unroll") for (int k = 0; k < 2; ++k) dst[n][k] = *(const PG8_LAS bf16x8*)(lds + PG8_SB(b, h) + boff + n * 2048 + k * 1024); } while (0)
#define PG8_MMA(ai, bj, At, Bt) do { __builtin_amdgcn_s_setprio(1); _Pragma("unroll") for (int m = 0; m < 4; ++m) _Pragma("unroll") for (int n = 0; n < 2; ++n) _Pragma("unroll") for (int k = 0; k < 2; ++k) \
        acc[ai][bj][m][n] = __builtin_amdgcn_mfma_f32_16x16x32_bf16(Bt[n][k], At[m][k], acc[ai][bj][m][n], 0, 0, 0); __builtin_amdgcn_s_setprio(0); } while (0)
#define PG8_WAIT_V(n) asm volatile("s_waitcnt vmcnt(" #n ")" ::: "memory")
#define PG8_WAIT_L(n) asm volatile("s_waitcnt lgkmcnt(" #n ")" ::: "memory")
#define PG8_BAR __builtin_amdgcn_s_barrier()
#define PG8_SCHED __builtin_amdgcn_sched_barrier(0)
    Unit cur, nxt; int ui = 0;
    if (!S.next(0, cur)) return;
    f32x4 acc[2][2][4][2];
#pragma unroll
    for (int a = 0; a < 2; ++a)
#pragma unroll
        for (int b = 0; b < 2; ++b)
#pragma unroll
            for (int m = 0; m < 4; ++m)
#pragma unroll
                for (int n = 0; n < 2; ++n) acc[a][b][m][n] = (f32x4){0.f, 0.f, 0.f, 0.f};
    bf16x8 At[4][2], B0[2][2], B1[2][2];
    const char* cA = GATHER ? (const char*)g.A : (const char*)g.A + (size_t)cur.pm * tstep; const char* cB = (const char*)g.Bt + (size_t)cur.pb * tstep;
    PG8_GOFF(voA, cur);
    if constexpr (GATHER) { _Pragma("unroll") for (int _h = 0; _h < 2; ++_h) _Pragma("unroll") for (int _i = 0; _i < 2; ++_i) voAn[_h][_i] = voA[_h][_i]; }
    if constexpr (SP2) {
        PG8_STAGE(PG8_SB(0, 0), cB, voffB); PG8_STAGE(PG8_SB(0, 1), cB + hstep, voffB); PG8_STA(0, 0, cA, false); PG8_STA(0, 1, cA, false);
        if (wr == 1) PG8_BAR;
        PG8_WAIT_V(2); PG8_BAR;
        PG8_STAGE(PG8_SB(1, 0), cB + kstep, voffB); PG8_STA(1, 0, cA + kstep, false); PG8_STAGE(PG8_SB(1, 1), cB + hstep + kstep, voffB);
        PG8_WAIT_V(6); PG8_BAR;
    } else {
        PG8_STAGE(PG8_SB(0, 0), cB, voffB); PG8_STA(0, 0, cA, false); PG8_STAGE(PG8_SB(0, 1), cB + hstep, voffB); PG8_STA(0, 1, cA, false);
        if (wr == 1) PG8_BAR;
        PG8_WAIT_V(4); PG8_BAR;
        PG8_STAGE(PG8_SB(1, 0), cB + kstep, voffB); PG8_STA(1, 0, cA + kstep, false); PG8_STAGE(PG8_SB(1, 1), cB + hstep + kstep, voffB);
        PG8_WAIT_V(6); PG8_BAR;
    }
    for (;;) {
        const bool has_next = S.next(ui + 1, nxt);
        if constexpr (GATHER) { if (has_next) { PG8_GOFF(voAn, nxt); asm volatile("s_waitcnt vmcnt(0)" ::: "memory"); } }
        const char* nA = GATHER ? cA : (has_next ? (const char*)g.A + (size_t)nxt.pm * tstep : cA); const char* nB = has_next ? (const char*)g.Bt + (size_t)nxt.pb * tstep : cB;
        for (int t = 0; t < nt; t += 2) {
            const bool last = (t == nt - 2);
            const bool NX = last && has_next;
            const char* a1 = cA + (size_t)(t + 1) * kstep;
            const char* a2 = last ? nA : cA + (size_t)(t + 2) * kstep; const char* b2 = last ? nB : cB + (size_t)(t + 2) * kstep;
            const char* a3 = a2 + kstep; const char* b3 = b2 + kstep;
            if constexpr (SP2) {
            PG8_LDB(B0, 0, 0); PG8_LDB(B1, 0, 1); PG8_SCHED; PG8_LDA(At, 0, 0); PG8_STA(1, 1, a1, false);
            PG8_WAIT_V(8); PG8_WAIT_L(0); PG8_BAR; PG8_MMA(0, 0, At, B0); PG8_MMA(0, 1, At, B1); PG8_BAR; PG8_SCHED;
            PG8_LDA(At, 0, 1); PG8_STAGE(PG8_SB(0, 0), b2, voffB); PG8_STAGE(PG8_SB(0, 1), b2 + hstep, voffB); PG8_STA(0, 0, a2, NX);
            PG8_WAIT_V(8); PG8_WAIT_L(0); PG8_BAR; PG8_MMA(1, 0, At, B0); PG8_MMA(1, 1, At, B1); PG8_BAR; PG8_SCHED;
            PG8_LDB(B0, 1, 0); PG8_LDB(B1, 1, 1); PG8_SCHED; PG8_LDA(At, 1, 0); PG8_STA(0, 1, a2, NX);
            PG8_WAIT_V(8); PG8_WAIT_L(0); PG8_BAR; PG8_MMA(0, 0, At, B0); PG8_MMA(0, 1, At, B1); PG8_BAR; PG8_SCHED;
            PG8_LDA(At, 1, 1); PG8_STAGE(PG8_SB(1, 0), b3, voffB); PG8_STAGE(PG8_SB(1, 1), b3 + hstep, voffB); PG8_STA(1, 0, a3, NX);
            PG8_WAIT_V(8); PG8_WAIT_L(0); PG8_BAR; PG8_MMA(1, 0, At, B0); PG8_MMA(1, 1, At, B1); PG8_BAR; PG8_SCHED;
            } else {
            PG8_LDB(B0, 0, 0); PG8_SCHED; PG8_LDA(At, 0, 0); PG8_STA(1, 1, a1, false);
            PG8_WAIT_L(8); PG8_BAR; PG8_WAIT_L(0); PG8_MMA(0, 0, At, B0); PG8_BAR; PG8_SCHED;
            PG8_LDB(B1, 0, 1); PG8_STAGE(PG8_SB(0, 0), b2, voffB);
            PG8_BAR; PG8_WAIT_L(0); PG8_MMA(0, 1, At, B1); PG8_BAR;
            PG8_LDA(At, 0, 1); PG8_STA(0, 0, a2, NX);
            PG8_BAR; PG8_WAIT_L(0); PG8_MMA(1, 0, At, B0); PG8_BAR; PG8_SCHED;
            PG8_STAGE(PG8_SB(0, 1), b2 + hstep, voffB);
            PG8_WAIT_V(6); PG8_BAR; PG8_MMA(1, 1, At, B1); PG8_BAR;
            PG8_LDB(B0, 1, 0); PG8_SCHED; PG8_LDA(At, 1, 0); PG8_STA(0, 1, a2, NX);
            PG8_WAIT_L(8); PG8_BAR; PG8_WAIT_L(0); PG8_MMA(0, 0, At, B0); PG8_BAR; PG8_SCHED;
            PG8_LDB(B1, 1, 1); PG8_STAGE(PG8_SB(1, 0), b3, voffB);
            PG8_BAR; PG8_WAIT_L(0); PG8_MMA(0, 1, At, B1); PG8_BAR;
            PG8_LDA(At, 1, 1); PG8_STA(1, 0, a3, NX);
            PG8_BAR; PG8_WAIT_L(0); PG8_MMA(1, 0, At, B0); PG8_BAR; PG8_SCHED;
            PG8_STAGE(PG8_SB(1, 1), b3 + hstep, voffB);
            PG8_WAIT_V(6); PG8_BAR; PG8_MMA(1, 1, At, B1); PG8_BAR;
            }
        }
        if constexpr (ALIGN_EPI) { if (wr == 0) PG8_BAR; }
        if constexpr (!Epi::AFTER_DRAIN) { int t2 = tid; asm volatile("" : "+v"(t2)); const int l2 = t2 & 63; E(acc, cur, wr, wc, l2 & 15, l2 >> 4); }
        if (!has_next) break;
#pragma unroll
        for (int a = 0; a < 2; ++a)
#pragma unroll
            for (int b = 0; b < 2; ++b)
#pragma unroll
                for (int m = 0; m < 4; ++m)
#pragma unroll
                    for (int n = 0; n < 2; ++n) acc[a][b][m][n] = (f32x4){0.f, 0.f, 0.f, 0.f};
        cur = nxt; cA = nA; cB = nB; ++ui;
        if constexpr (GATHER) { _Pragma("unroll") for (int _h = 0; _h < 2; ++_h) _Pragma("unroll") for (int _i = 0; _i < 2; ++_i) voA[_h][_i] = voAn[_h][_i]; }
        if constexpr (ALIGN_EPI) { if (wr == 1) PG8_BAR; }
    }
    PG8_WAIT_V(0);
    if constexpr (!ALIGN_EPI) { if (wr == 0) PG8_BAR; }
    PG8_BAR;
    if constexpr (Epi::AFTER_DRAIN) { int t2 = tid; asm volatile("" : "+v"(t2)); const int l2 = t2 & 63; E.fused(acc, cur, wr, wc, l2 & 15, l2 >> 4, lds, wid, l2); }
#undef PG8_GOFF
#undef PG8_SA
#undef PG8_SB
#undef PG8_STAGE
#undef PG8_STA
#undef PG8_LDA
#undef PG8_LDB
#undef PG8_MMA
#undef PG8_WAIT_V
#undef PG8_WAIT_L
#undef PG8_BAR
#undef PG8_SCHED
}
}
#define GAS __attribute__((address_space(1)))
#define LAS __attribute__((address_space(3)))
typedef unsigned short bf16;
typedef unsigned v4u __attribute__((ext_vector_type(4)));
typedef float f32x4 __attribute__((ext_vector_type(4)));
typedef short bf16x8 __attribute__((ext_vector_type(8)));
typedef GAS unsigned gu32;
typedef GAS unsigned long long gu64;
#define RLX_AGENT __ATOMIC_RELAXED, __HIP_MEMORY_SCOPE_AGENT
#define LDS_WAIT() asm volatile("s_waitcnt lgkmcnt(0)" ::: "memory")
#define VM_WAIT() asm volatile("s_waitcnt vmcnt(0)" ::: "memory")
__device__ __forceinline__ unsigned long long rt() { return __builtin_amdgcn_s_memrealtime(); }
__device__ __forceinline__ unsigned f2bf(float f) { unsigned u = __builtin_bit_cast(unsigned, f); return (u + 0x7fffu + ((u >> 16) & 1u)) >> 16; }
__device__ __forceinline__ unsigned pk2(float lo, float hi) { return f2bf(lo) | (f2bf(hi) << 16); }

#define XB_TMO      128
#define XB_XCNT(j)  (256  + 64 * (j))
#define XB_XSUB(j)  (1280 + 64 * (j))
#define XB_XGEN(j)  (2304 + 64 * (j))
#define XB_TOP      3328
#define XB_TOPGEN   3392
#define XCD_BAR_WORDS 3456
#define XB_SPIN_CAP (1u << 18)

__device__ __forceinline__ unsigned xb_ld(unsigned* p)              { return __hip_atomic_load(p, __ATOMIC_RELAXED, __HIP_MEMORY_SCOPE_AGENT); }
__device__ __forceinline__ unsigned xb_add(unsigned* p, unsigned v) { return __hip_atomic_fetch_add(p, v, __ATOMIC_RELAXED, __HIP_MEMORY_SCOPE_AGENT); }
__device__ __forceinline__ unsigned xb_xcc_id() { return (unsigned)__builtin_amdgcn_s_getreg((3 << 11) | 20) & 0xFu; }
#define XB_SPIN(cond, bar) do { unsigned _sp = 0; while (cond) { __builtin_amdgcn_s_sleep(1); \
    if ((++_sp & 255u) == 0u) { if (xb_ld(&(bar)[XB_TMO])) break; if (_sp > XB_SPIN_CAP) { atomicAdd(&(bar)[XB_TMO], 1u); break; } } } } while (0)

struct XcdBarrier {
    unsigned* bar; unsigned x;
    volatile LAS unsigned* st;
};

__device__ __forceinline__ XcdBarrier xcd_barrier_post(unsigned* bar, volatile LAS unsigned* st) {
    XcdBarrier b; b.bar = bar; b.x = xb_xcc_id(); b.st = st;
    if (threadIdx.x == 0) (void)xb_add(&bar[XB_XCNT(b.x)], 1u);
    return b;
}
__device__ __forceinline__ void xcd_barrier_complete(unsigned* bar, unsigned x, unsigned& nloc, unsigned& nx) {
    const unsigned G = gridDim.x * gridDim.y * gridDim.z;
    unsigned sum, cnt, mine, sp = 0u;
    for (;;) {
        sum = 0u; cnt = 0u; mine = 0u;
#pragma unroll
        for (unsigned j = 0; j < 16; ++j) { const unsigned c = xb_ld(&bar[XB_XCNT(j)]); sum += c; cnt += (c > 0u) ? 1u : 0u; mine = (j == x) ? c : mine; }
        if (sum == G) break;
        __builtin_amdgcn_s_sleep(1);
        if ((++sp & 255u) == 0u) { if (xb_ld(&bar[XB_TMO])) break; if (sp > XB_SPIN_CAP) { atomicAdd(&bar[XB_TMO], 1u); break; } }
    }
    nloc = mine > 0u ? mine : 1u; nx = cnt > 0u ? cnt : 1u;
}

__device__ __forceinline__ void xcd_barrier(const XcdBarrier& b) {
    asm volatile("s_waitcnt vmcnt(0)" ::: "memory");
    __syncthreads();
    if (threadIdx.x == 0) {
        unsigned* bar = b.bar;
        __builtin_amdgcn_s_waitcnt(0);
        unsigned nloc = b.st[0], nx = b.st[1];
        if (nloc == 0u) { xcd_barrier_complete(bar, b.x, nloc, nx); b.st[0] = nloc; b.st[1] = nx; }
        const unsigned old = xb_add(&bar[XB_XSUB(b.x)], 1u);
        const unsigned gen = old / nloc;
        if (old + 1u == (gen + 1u) * nloc) {
            __builtin_amdgcn_fence(__ATOMIC_RELEASE, "agent");
            asm volatile("s_waitcnt vmcnt(0)" ::: "memory");
            const unsigned og = xb_add(&bar[XB_TOP], 1u);
            const unsigned tg = og / nx;
            if (og + 1u == (tg + 1u) * nx) xb_add(&bar[XB_TOPGEN], 1u);
            else XB_SPIN(xb_ld(&bar[XB_TOPGEN]) == tg, bar);
            __builtin_amdgcn_fence(__ATOMIC_ACQUIRE, "agent");
            xb_add(&bar[XB_XGEN(b.x)], 1u);
            asm volatile("s_waitcnt vmcnt(0)" ::: "memory");
        } else {
            XB_SPIN(xb_ld(&bar[XB_XGEN(b.x)]) == gen, bar);
            __builtin_amdgcn_fence(__ATOMIC_ACQUIRE, "agent");
            asm volatile("s_waitcnt vmcnt(0)" ::: "memory");
        }
    }
    __syncthreads();
}
constexpr int NWAVES = 8;
constexpr int BATCH = 8, SEQ = 2048, D = 1024, NH = 16, HD = 64, DEPTH = 4;
constexpr int M = BATCH * SEQ;
constexpr int NQKV = 3 * D, DV = 3072, NZ = 2 * DV, GG = 8, GD = 384, CHK = 128;
constexpr int NE = 64, EPG = 8, FE = 256, NRT = 80;
constexpr float LN_EPS = 1e-5f, ALPHA = 1.681792830507429f;
constexpr float QSCALE = 0.125f * 1.4426950408889634f;
constexpr int TOKCAP = 16384;
constexpr int MAXTILES = 192;

constexpr size_t MiB = 1u << 20;
constexpr size_t WS_CTL = 0, CTL_ZERO_BYTES = 1 * MiB;
constexpr size_t WS_WQKV = 2 * MiB;
constexpr size_t WS_WO = 14 * MiB;
constexpr size_t WS_WIN = 18 * MiB;
constexpr size_t WS_WOUT = 42 * MiB;
constexpr size_t WS_WR = 54 * MiB;
constexpr size_t WS_XB = 56 * MiB;
constexpr size_t WS_KSUM = 57 * MiB;
constexpr size_t WS_VPART = 58 * MiB;
constexpr size_t WS_TOK = 64 * MiB;
constexpr size_t WS_ASG = 68 * MiB;
constexpr size_t WS_XN = 72 * MiB;
constexpr size_t WS_QO = 104 * MiB, WS_K = 136 * MiB, WS_V = 168 * MiB;
constexpr size_t WS_U = 104 * MiB, WS_VV = 200 * MiB;
constexpr size_t WS_HB = 296 * MiB;
constexpr size_t WS_YB = 320 * MiB;
constexpr size_t WS_W13 = 416 * MiB;
constexpr size_t WS_W2 = 672 * MiB;
constexpr size_t WS_END = 800 * MiB;
constexpr int CW_TMO = 0, CW_CODE = 1;
constexpr int CW_BAR = 4096;
constexpr int CW_SEAM = 16384;
constexpr int CW_CNT = 32768;
constexpr int RING_OFF = 0, RING_BYTES = 131072;
constexpr int LDSCTL_OFF = RING_BYTES, MISC_OFF = LDSCTL_OFF + 320;
constexpr int TAB_OFF = LDSCTL_OFF + 1024;
constexpr int LDS_BYTES = 147456;

struct Args { const float* in[21]; float* out; unsigned char* ws; int ph_lo, ph_hi; };
struct Frame {
    LAS unsigned char* lds;
    volatile LAS unsigned* MISC;
    gu32* ctl;
    int tid, lane, wave;
    int vcu, G;
    float* out; unsigned char* ws;
    bf16 *XN, *QO, *KB, *VB, *UB, *VVB, *HB, *YB;
};
__device__ __forceinline__ float wave_sum(float v) {
#pragma unroll
    for (int o = 1; o < 64; o <<= 1) v += __shfl_xor(v, o);
    return v;
}
__device__ __forceinline__ float bflo(unsigned w) { return __uint_as_float(w << 16); }
__device__ __forceinline__ float bfhi(unsigned w) { return __uint_as_float(w & 0xffff0000u); }
template <class T> __device__ __forceinline__ T* opaque(T* p) { asm volatile("" : "+v"(p)); return p; }

__device__ __forceinline__ void p0_transpose_tile(const float* W, int N, int k0, int n0, bf16* WTrow, int ldt, LAS float* scr, int lane) {
#pragma unroll 4
    for (int i = 0; i < 32; ++i) { const int kk = 2 * i + (lane >> 5); scr[kk * 33 + (lane & 31)] = W[(size_t)(k0 + kk) * N + n0 + (lane & 31)]; }
    LDS_WAIT(); asm volatile("" ::: "memory");
    const int c = lane & 7;
#pragma unroll
    for (int j = 0; j < 4; ++j) { const int n = (lane >> 3) + 8 * j; const LAS float* s = scr + (8 * c) * 33 + n;
        v4u o; o.x = pk2(s[0 * 33], s[1 * 33]); o.y = pk2(s[2 * 33], s[3 * 33]); o.z = pk2(s[4 * 33], s[5 * 33]); o.w = pk2(s[6 * 33], s[7 * 33]);
        *(GAS v4u*)(WTrow + (size_t)n * ldt + k0 + 8 * c) = o; }
    LDS_WAIT(); asm volatile("" ::: "memory");
}
__device__ __forceinline__ void p0_prologue(Frame& F, const Args& A) {
    LAS float* scr = (LAS float*)(F.lds + RING_OFF + F.wave * 16384);
    const int gw = F.vcu * NWAVES + F.wave, NGW = F.G * NWAVES;
    unsigned char* ws = F.ws;
    constexpr int I_QKV = 16 * 96, I_WO = 16 * 32, I_WIN = 16 * 192, I_WOUT = 48 * 32, I_DENSE = 2 * (I_QKV + I_WO + I_WIN + I_WOUT);
    constexpr int I_E = 128, I_MOE = DEPTH * NE * 3 * I_E;
    for (int it = gw; it < I_DENSE + I_MOE; it += NGW) {
        int r = it;
        if (r < I_DENSE) {
            if (r < 2 * I_QKV) { const int j = r / I_QKV; r %= I_QKV; const int kb = r / 96, nb = r % 96;
                p0_transpose_tile(A.in[1] + (size_t)j * D * NQKV, NQKV, kb * 64, nb * 32, (bf16*)(ws + WS_WQKV) + (size_t)j * NQKV * D + (size_t)(nb * 32) * D, D, scr, F.lane); continue; } r -= 2 * I_QKV;
            if (r < 2 * I_WO) { const int j = r / I_WO; r %= I_WO; const int kb = r / 32, nb = r % 32;
                p0_transpose_tile(A.in[2] + (size_t)j * D * D, D, kb * 64, nb * 32, (bf16*)(ws + WS_WO) + (size_t)j * D * D + (size_t)(nb * 32) * D, D, scr, F.lane); continue; } r -= 2 * I_WO;
            if (r < 2 * I_WIN) { const int j = r / I_WIN; r %= I_WIN; const int kb = r / 192, nb = r % 192;
                p0_transpose_tile(A.in[3] + (size_t)j * D * NZ, NZ, kb * 64, nb * 32, (bf16*)(ws + WS_WIN) + (size_t)j * NZ * D + (size_t)(nb * 32) * D, D, scr, F.lane); continue; } r -= 2 * I_WIN;
            { const int j = r / I_WOUT; r %= I_WOUT; const int kb = r / 32, nb = r % 32;
                p0_transpose_tile(A.in[9] + (size_t)j * DV * D, D, kb * 64, nb * 32, (bf16*)(ws + WS_WOUT) + (size_t)j * D * DV + (size_t)(nb * 32) * DV, DV, scr, F.lane); continue; }
        }
        r -= I_DENSE;
        const int le = r / (3 * I_E); r %= 3 * I_E; const int which = r / I_E; r %= I_E;
        if (which < 2) {
            const int kb = r / 8, nb = r % 8, n0 = nb * 32;
            p0_transpose_tile(A.in[18 + which] + (size_t)le * D * FE, FE, kb * 64, n0, (bf16*)(ws + WS_W13) + (size_t)le * 512 * D + (size_t)((n0 >> 7) * 256 + which * 128 + (n0 & 127)) * D, D, scr, F.lane);
        } else {
            const int kb = r / 32, nb = r % 32;
            p0_transpose_tile(A.in[20] + (size_t)le * FE * D, D, kb * 64, nb * 32, (bf16*)(ws + WS_W2) + (size_t)le * D * FE + (size_t)(nb * 32) * FE, FE, scr, F.lane);
        }
    }
    const int gt = F.vcu * (NWAVES * 64) + F.tid, NGT = F.G * NWAVES * 64;
    for (int idx = gt; idx < DEPTH * NRT * D; idx += NGT) {
        const int l = idx / (NRT * D), n = (idx / D) % NRT, k = idx % D;
        float w = 0.f; if (n < 8) w = A.in[14][((size_t)l * D + k) * 8 + n]; else if (n < 72) w = A.in[16][((size_t)l * D + k) * NE + (n - 8)];
        const unsigned hi = f2bf(w); const float lo = w - __uint_as_float(hi << 16);
        bf16* wr = (bf16*)(ws + WS_WR) + (size_t)l * 2 * NRT * D + (size_t)n * D + k;
        wr[0] = (bf16)hi; wr[(size_t)NRT * D] = (bf16)f2bf(lo);
    }
    for (int idx = gt; idx < M * D / 8; idx += NGT) {
        const f32x4 a = ((const f32x4*)A.in[0])[2 * idx], b = ((const f32x4*)A.in[0])[2 * idx + 1];
        v4u o; o.x = pk2(a[0], a[1]); o.y = pk2(a[2], a[3]); o.z = pk2(b[0], b[1]); o.w = pk2(b[2], b[3]);
        ((GAS v4u*)F.XN)[idx] = o;
    }
}

__device__ __forceinline__ void attn_naive_phase(Frame& F) {
    const int gw = F.vcu * NWAVES + F.wave, NGW = F.G * NWAVES;
    const float* ks = (const float*)(F.ws + WS_KSUM);
    for (int wu = gw; wu < BATCH * NH * (SEQ / 64); wu += NGW) {
        const int bh = wu / (SEQ / 64), qc = wu % (SEQ / 64), b = bh / NH, h = bh % NH;
        const int q = qc * 64 + F.lane, qb = (qc * 64) >> 8;
        const size_t rowq = (size_t)b * SEQ + q;
        unsigned qp[32];
        { const v4u* qg = (const v4u*)(F.QO + rowq * D + h * HD);
#pragma unroll
          for (int c = 0; c < 8; ++c) { const v4u w = qg[c]; qp[4 * c + 0] = w.x; qp[4 * c + 1] = w.y; qp[4 * c + 2] = w.z; qp[4 * c + 3] = w.w; } }
        unsigned sel = (1u << qb) - 1u;
        if (qb > 3) {
            float t0 = -INFINITY, t1 = -INFINITY, t2 = -INFINITY; int i0 = 0, i1 = 0, i2 = 0;
#pragma unroll 1
            for (int j = 0; j < qb; ++j) {
                const f32x4* k0 = opaque((const f32x4*)(ks + ((size_t)(b * 8 + j)) * 1024 + h * HD)); const f32x4* k1 = k0 + (size_t)64 * 256; float s = 0.f;
#pragma unroll
                for (int c = 0; c < 8; ++c) { const f32x4 a0 = k0[2 * c] + k1[2 * c], a1 = k0[2 * c + 1] + k1[2 * c + 1];
                    s += bflo(qp[4 * c + 0]) * a0[0] + bfhi(qp[4 * c + 0]) * a0[1] + bflo(qp[4 * c + 1]) * a0[2] + bfhi(qp[4 * c + 1]) * a0[3]
                       + bflo(qp[4 * c + 2]) * a1[0] + bfhi(qp[4 * c + 2]) * a1[1] + bflo(qp[4 * c + 3]) * a1[2] + bfhi(qp[4 * c + 3]) * a1[3]; }
                asm volatile("" : "+v"(s));
                if (s > t0) { t2 = t1; i2 = i1; t1 = t0; i1 = i0; t0 = s; i0 = j; } else if (s > t1) { t2 = t1; i2 = i1; t1 = s; i1 = j; } else if (s > t2) { t2 = s; i2 = j; }
            }
            sel = (1u << i0) | (1u << i1) | (1u << i2);
        }
        float mx = -INFINITY, l = 0.f, o[64];
#pragma unroll
        for (int d = 0; d < 64; ++d) o[d] = 0.f;
        for (int j = 0; j <= qb; ++j) {
            const bool use = (j == qb) || ((sel >> j) & 1u);
            const int kend = (j == qb) ? (qc * 64 + 64 - qb * 256) : 256;
#pragma unroll 1
            for (int kk = 0; kk < kend; ++kk) {
                const int key = j * 256 + kk;
                const v4u* kp = opaque((const v4u*)(F.KB + ((size_t)b * SEQ + key) * D + h * HD));
                float s = 0.f;
#pragma unroll
                for (int c = 0; c < 8; ++c) { const v4u w = kp[c]; s += bflo(qp[4 * c + 0]) * bflo(w.x) + bfhi(qp[4 * c + 0]) * bfhi(w.x) + bflo(qp[4 * c + 1]) * bflo(w.y) + bfhi(qp[4 * c + 1]) * bfhi(w.y)
                    + bflo(qp[4 * c + 2]) * bflo(w.z) + bfhi(qp[4 * c + 2]) * bfhi(w.z) + bflo(qp[4 * c + 3]) * bflo(w.w) + bfhi(qp[4 * c + 3]) * bfhi(w.w); }
                asm volatile("" : "+v"(s));
                const bool ok = use && (key <= q);
                const float mn = ok ? fmaxf(mx, s) : mx;
                const float a = (mn == mx) ? 1.0f : __builtin_amdgcn_exp2f(mx - mn);
                const float p = ok ? __builtin_amdgcn_exp2f(s - mn) : 0.f;
                l = l * a + p; mx = mn;
                const v4u* vp = opaque((const v4u*)(F.VB + ((size_t)b * SEQ + key) * D + h * HD));
#pragma unroll
                for (int c = 0; c < 8; ++c) { const v4u w = vp[c];
                    o[8 * c + 0] = o[8 * c + 0] * a + p * bflo(w.x); o[8 * c + 1] = o[8 * c + 1] * a + p * bfhi(w.x); o[8 * c + 2] = o[8 * c + 2] * a + p * bflo(w.y); o[8 * c + 3] = o[8 * c + 3] * a + p * bfhi(w.y);
                    o[8 * c + 4] = o[8 * c + 4] * a + p * bflo(w.z); o[8 * c + 5] = o[8 * c + 5] * a + p * bfhi(w.z); o[8 * c + 6] = o[8 * c + 6] * a + p * bflo(w.w); o[8 * c + 7] = o[8 * c + 7] * a + p * bfhi(w.w); }
            }
        }
        const float rl = 1.0f / l;
        GAS v4u* op = (GAS v4u*)(F.QO + rowq * D + h * HD);
#pragma unroll
        for (int c = 0; c < 8; ++c) { v4u w; w.x = pk2(o[8 * c + 0] * rl, o[8 * c + 1] * rl); w.y = pk2(o[8 * c + 2] * rl, o[8 * c + 3] * rl); w.z = pk2(o[8 * c + 4] * rl, o[8 * c + 5] * rl); w.w = pk2(o[8 * c + 6] * rl, o[8 * c + 7] * rl); op[c] = w; }
    }
}

__device__ __forceinline__ void resln_phase(Frame& F, const bf16* Hout, const float* g, const float* bta) {
    const int gw = F.vcu * NWAVES + F.wave, NGW = F.G * NWAVES;
    for (int row = gw; row < M; row += NGW) {
        float v[16];
#pragma unroll
        for (int hf = 0; hf < 2; ++hf) { const v4u x = *(const v4u*)(F.XN + (size_t)row * D + hf * 512 + F.lane * 8), y = *(const v4u*)(Hout + (size_t)row * D + hf * 512 + F.lane * 8);
            v[8 * hf + 0] = ALPHA * bflo(x.x) + bflo(y.x); v[8 * hf + 1] = ALPHA * bfhi(x.x) + bfhi(y.x); v[8 * hf + 2] = ALPHA * bflo(x.y) + bflo(y.y); v[8 * hf + 3] = ALPHA * bfhi(x.y) + bfhi(y.y);
            v[8 * hf + 4] = ALPHA * bflo(x.z) + bflo(y.z); v[8 * hf + 5] = ALPHA * bfhi(x.z) + bfhi(y.z); v[8 * hf + 6] = ALPHA * bflo(x.w) + bflo(y.w); v[8 * hf + 7] = ALPHA * bfhi(x.w) + bfhi(y.w); }
        float s = 0.f;
#pragma unroll
        for (int i = 0; i < 16; ++i) s += v[i];
        const float mean = wave_sum(s) * (1.f / D); float s2 = 0.f;
#pragma unroll
        for (int i = 0; i < 16; ++i) { v[i] -= mean; s2 += v[i] * v[i]; }
        const float rstd = 1.f / sqrtf(wave_sum(s2) * (1.f / D) + LN_EPS);
#pragma unroll
        for (int hf = 0; hf < 2; ++hf) { const int c0 = hf * 512 + F.lane * 8; const f32x4 g0 = *(const f32x4*)(g + c0), g1 = *(const f32x4*)(g + c0 + 4), b0 = *(const f32x4*)(bta + c0), b1 = *(const f32x4*)(bta + c0 + 4);
            v4u o; o.x = pk2(v[8 * hf + 0] * rstd * g0[0] + b0[0], v[8 * hf + 1] * rstd * g0[1] + b0[1]); o.y = pk2(v[8 * hf + 2] * rstd * g0[2] + b0[2], v[8 * hf + 3] * rstd * g0[3] + b0[3]);
            o.z = pk2(v[8 * hf + 4] * rstd * g1[0] + b1[0], v[8 * hf + 5] * rstd * g1[1] + b1[1]); o.w = pk2(v[8 * hf + 6] * rstd * g1[2] + b1[2], v[8 * hf + 7] * rstd * g1[3] + b1[3]);
            *(GAS v4u*)(F.XN + (size_t)row * D + c0) = o; }
    }
}

__device__ __forceinline__ void router_phase(Frame& F, const Args& A, int l) {
    const int rg = F.wave & 3, kh = F.wave >> 2, fr = F.lane & 15, fq = F.lane >> 4;
    const bf16* Wr = (const bf16*)(F.ws + WS_WR) + (size_t)l * 2 * NRT * D;
    LAS float* part = (LAS float*)(F.lds + RING_OFF);
    int* tok = (int*)(F.ws + WS_TOK); int* asg = (int*)(F.ws + WS_ASG); float* gate = (float*)(F.ws + WS_ASG + 128 * 1024);
    for (int rb = F.vcu; rb < M / 64; rb += F.G) {
        const int row0 = rb * 64;
        const bf16* ap = F.XN + (size_t)(row0 + rg * 16 + fr) * D + kh * 512 + fq * 8;
        const bf16* bp = Wr + (size_t)fr * D + kh * 512 + fq * 8;
        f32x4 acc[5];
#pragma unroll
        for (int nf = 0; nf < 5; ++nf) acc[nf] = (f32x4){0.f, 0.f, 0.f, 0.f};
#pragma unroll 1
        for (int ks = 0; ks < 16; ++ks) {
            const bf16x8 a = *(const bf16x8*)(ap + ks * 32);
#pragma unroll
            for (int nf = 0; nf < 5; ++nf) {
                const bf16x8 bh = *(const bf16x8*)(bp + (size_t)nf * 16 * D + ks * 32), bl = *(const bf16x8*)(bp + (size_t)(NRT + nf * 16) * D + ks * 32);
                acc[nf] = __builtin_amdgcn_mfma_f32_16x16x32_bf16(a, bh, acc[nf], 0, 0, 0);
                acc[nf] = __builtin_amdgcn_mfma_f32_16x16x32_bf16(a, bl, acc[nf], 0, 0, 0);
            }
        }
#pragma unroll
        for (int nf = 0; nf < 5; ++nf)
#pragma unroll
            for (int j = 0; j < 4; ++j) part[(kh * 64 + rg * 16 + fq * 4 + j) * NRT + nf * 16 + fr] = acc[nf][j];
        __syncthreads();
        if (F.tid < 64) {
            const int t = F.tid, token = row0 + t;
            const LAS float* p0 = part + t * NRT; const LAS float* p1 = part + (64 + t) * NRT;
            float gl[8]; float gmax = -INFINITY; int gi = 0;
#pragma unroll
            for (int j = 0; j < 8; ++j) { gl[j] = p0[j] + p1[j] + A.in[15][l * 8 + j]; if (gl[j] > gmax) { gmax = gl[j]; gi = j; } }
            float gs = 0.f;
#pragma unroll
            for (int j = 0; j < 8; ++j) gs += __expf(gl[j] - gmax);
            const float gp = 1.0f / gs;
            float v0 = -INFINITY, v1 = -INFINITY; int i0 = 0, i1 = 0;
#pragma unroll
            for (int j = 0; j < 8; ++j) { const float e = p0[8 + gi * 8 + j] + p1[8 + gi * 8 + j] + A.in[17][l * NE + gi * 8 + j];
                if (e > v0) { v1 = v0; i1 = i0; v0 = e; i0 = j; } else if (e > v1) { v1 = e; i1 = j; } }
            const float pa = 1.0f / (1.0f + __expf(v1 - v0)), pb = 1.0f - pa;
            const int e0 = gi * 8 + i0, e1 = gi * 8 + i1;
            const unsigned q0 = __hip_atomic_fetch_add((unsigned*)(F.ctl + CW_CNT + l * NE + e0), 1u, RLX_AGENT);
            const unsigned q1 = __hip_atomic_fetch_add((unsigned*)(F.ctl + CW_CNT + l * NE + e1), 1u, RLX_AGENT);
            tok[e0 * TOKCAP + q0] = token; tok[e1 * TOKCAP + q1] = token;
            asg[token * 2 + 0] = (e0 << 16) | (int)q0; asg[token * 2 + 1] = (e1 << 16) | (int)q1;
            gate[token * 2 + 0] = gp * pa; gate[token * 2 + 1] = gp * pb;
        }
        __syncthreads();
    }
}

__device__ __forceinline__ int moe_tables(Frame& F, int l) {
    LAS int* cnt = (LAS int*)(F.lds + TAB_OFF); LAS int* tstart = cnt + 64; LAS int* tile_e = cnt + 64 + 68;
    if (F.tid < 64) cnt[F.tid] = (int)__hip_atomic_load(F.ctl + CW_CNT + l * NE + F.tid, RLX_AGENT);
    __syncthreads();
    if (F.tid == 0) { int s = 0; for (int e = 0; e < NE; ++e) { tstart[e] = s; s += (cnt[e] + 255) >> 8; } tstart[NE] = s; }
    __syncthreads();
    const int ntiles = tstart[NE];
    if (F.tid < ntiles && F.tid < 256) { int e = 0; for (int k = 0; k < NE; ++k) if (tstart[k + 1] <= F.tid) e = k + 1; tile_e[F.tid] = e; }
    __syncthreads();
    return ntiles < MAXTILES ? ntiles : MAXTILES;
}
struct MoeOrder {
    int ntiles, npn, G, c; const LAS int* cnt; const LAS int* tstart; const LAS int* tile_e;
    __device__ __forceinline__ bool next(int i, pg8::Unit& u) const {
        const int L = i * G + c; if (L >= ntiles * npn) return false;
        const int tile = L / npn, pn = L % npn, e = tile_e[tile], chunk = tile - tstart[e];
        u.pm = tile; u.pn = pn; u.pb = e * npn + pn; u.gofs = e * TOKCAP + chunk * 256; const int left = cnt[e] - chunk * 256; u.gcnt = left < 256 ? left : 256; return true;
    }
};

__device__ __forceinline__ void combine_phase(Frame& F, int l, const float* g, const float* bta, bool last_layer) {
    const LAS int* tstart = (const LAS int*)(F.lds + TAB_OFF) + 64;
    const int gw = F.vcu * NWAVES + F.wave, NGW = F.G * NWAVES;
    const int* asg = (const int*)(F.ws + WS_ASG); const float* gate = (const float*)(F.ws + WS_ASG + 128 * 1024);
    for (int row = gw; row < M; row += NGW) {
        const int* ap = opaque(asg + row * 2); const float* gp = opaque(gate + row * 2);
        const int a0 = ap[0], a1 = ap[1]; const float g0 = gp[0], g1 = gp[1];
        const size_t r0 = (size_t)tstart[a0 >> 16] * 256 + (a0 & 0xffff), r1 = (size_t)tstart[a1 >> 16] * 256 + (a1 & 0xffff);
        float v[16];
#pragma unroll
        for (int hf = 0; hf < 2; ++hf) { const int c0 = hf * 512 + F.lane * 8;
            const v4u x = *(const v4u*)(F.XN + (size_t)row * D + c0), y = *(const v4u*)(F.YB + r0 * D + c0), z = *(const v4u*)(F.YB + r1 * D + c0);
            v[8 * hf + 0] = ALPHA * bflo(x.x) + g0 * bflo(y.x) + g1 * bflo(z.x); v[8 * hf + 1] = ALPHA * bfhi(x.x) + g0 * bfhi(y.x) + g1 * bfhi(z.x);
            v[8 * hf + 2] = ALPHA * bflo(x.y) + g0 * bflo(y.y) + g1 * bflo(z.y); v[8 * hf + 3] = ALPHA * bfhi(x.y) + g0 * bfhi(y.y) + g1 * bfhi(z.y);
            v[8 * hf + 4] = ALPHA * bflo(x.z) + g0 * bflo(y.z) + g1 * bflo(z.z); v[8 * hf + 5] = ALPHA * bfhi(x.z) + g0 * bfhi(y.z) + g1 * bfhi(z.z);
            v[8 * hf + 6] = ALPHA * bflo(x.w) + g0 * bflo(y.w) + g1 * bflo(z.w); v[8 * hf + 7] = ALPHA * bfhi(x.w) + g0 * bfhi(y.w) + g1 * bfhi(z.w); }
        float s = 0.f;
#pragma unroll
        for (int i = 0; i < 16; ++i) s += v[i];
        const float mean = wave_sum(s) * (1.f / D); float s2 = 0.f;
#pragma unroll
        for (int i = 0; i < 16; ++i) { v[i] -= mean; s2 += v[i] * v[i]; }
        const float rstd = 1.f / sqrtf(wave_sum(s2) * (1.f / D) + LN_EPS);
#pragma unroll
        for (int hf = 0; hf < 2; ++hf) { const int c0 = hf * 512 + F.lane * 8; const f32x4 g0v = *(const f32x4*)(g + c0), g1v = *(const f32x4*)(g + c0 + 4), b0 = *(const f32x4*)(bta + c0), b1 = *(const f32x4*)(bta + c0 + 4);
            float o[8];
#pragma unroll
            for (int i = 0; i < 4; ++i) { o[i] = v[8 * hf + i] * rstd * g0v[i] + b0[i]; o[4 + i] = v[8 * hf + 4 + i] * rstd * g1v[i] + b1[i]; }
            if (last_layer) { GAS f32x4* op = (GAS f32x4*)(F.out + (size_t)row * D + c0); op[0] = (f32x4){o[0], o[1], o[2], o[3]}; op[1] = (f32x4){o[4], o[5], o[6], o[7]}; }
            else { v4u w; w.x = pk2(o[0], o[1]); w.y = pk2(o[2], o[3]); w.z = pk2(o[4], o[5]); w.w = pk2(o[6], o[7]); *(GAS v4u*)(F.XN + (size_t)row * D + c0) = w; } }
    }
}

__device__ __forceinline__ void g2a_phase(Frame& F) {
    typedef float f32x2v __attribute__((ext_vector_type(2)));
    const int gt = F.vcu * (NWAVES * 64) + F.tid, NGT = F.G * NWAVES * 64;
    const f32x2v* vp = (const f32x2v*)(F.ws + WS_VPART); f32x2v* vs = (f32x2v*)(F.ws + WS_ASG + 256 * 1024);
    for (int row = gt; row < M; row += NGT) { float s1 = 0.f, s2 = 0.f;
        for (int i = 0; i < 48; ++i) { const f32x2v p = vp[(size_t)row * 48 + i]; s1 += p.x; s2 += p.y; }
        const float mean = s1 * (1.f / DV), var = s2 * (1.f / DV) - mean * mean;
        vs[row] = (f32x2v){mean, 1.f / sqrtf(fmaxf(var, 0.f) + LN_EPS)}; }
}
__device__ __forceinline__ void g2b_naive_phase(Frame& F, const Args& A, int j) {
    typedef float f32x2v __attribute__((ext_vector_type(2)));
    const int gt = F.vcu * (NWAVES * 64) + F.tid, NGT = F.G * NWAVES * 64;
    const f32x2v* vs = (const f32x2v*)(F.ws + WS_ASG + 256 * 1024);
    const float* lg = A.in[5] + (size_t)j * DV; const float* lb = A.in[6] + (size_t)j * DV;
    const float* Ws = A.in[7] + (size_t)j * GG * CHK * CHK; const float* bs = A.in[8] + (size_t)j * GG * CHK;
    for (int id = gt; id < M * (DV / 8); id += NGT) {
        const int row = id / (DV / 8), k0 = (id % (DV / 8)) * 8, g = k0 / GD, t = row & (CHK - 1), r0 = row - t;
        float gk[8], bk[8], acc[8];
#pragma unroll
        for (int i = 0; i < 8; ++i) { gk[i] = lg[k0 + i]; bk[i] = lb[k0 + i]; acc[i] = 0.f; }
        const float* wrow = Ws + ((size_t)g * CHK + t) * CHK;
        for (int s = 0; s <= t; ++s) {
            const float w = wrow[s]; const f32x2v st = vs[r0 + s];
            const v4u vv = *(const v4u*)(F.VVB + (size_t)(r0 + s) * DV + k0);
            const float ws_ = w * st.y;
            acc[0] += ws_ * (bflo(vv.x) - st.x) * gk[0] + w * bk[0]; acc[1] += ws_ * (bfhi(vv.x) - st.x) * gk[1] + w * bk[1];
            acc[2] += ws_ * (bflo(vv.y) - st.x) * gk[2] + w * bk[2]; acc[3] += ws_ * (bfhi(vv.y) - st.x) * gk[3] + w * bk[3];
            acc[4] += ws_ * (bflo(vv.z) - st.x) * gk[4] + w * bk[4]; acc[5] += ws_ * (bfhi(vv.z) - st.x) * gk[5] + w * bk[5];
            acc[6] += ws_ * (bflo(vv.w) - st.x) * gk[6] + w * bk[6]; acc[7] += ws_ * (bfhi(vv.w) - st.x) * gk[7] + w * bk[7];
        }
        const float bt = bs[g * CHK + t];
        const v4u uu = *(const v4u*)(F.UB + (size_t)row * DV + k0);
        v4u o; o.x = pk2(bflo(uu.x) * (acc[0] + bt), bfhi(uu.x) * (acc[1] + bt)); o.y = pk2(bflo(uu.y) * (acc[2] + bt), bfhi(uu.y) * (acc[3] + bt));
        o.z = pk2(bflo(uu.z) * (acc[4] + bt), bfhi(uu.z) * (acc[5] + bt)); o.w = pk2(bflo(uu.w) * (acc[6] + bt), bfhi(uu.w) * (acc[7] + bt));
        *(GAS v4u*)(F.UB + (size_t)row * DV + k0) = o;
    }
}

constexpr int NPHASES = 1 + 2 * 8 + 2 * 9;
#ifndef MK_N_LAUNCHES
#define MK_N_LAUNCHES 1
#endif
#ifndef PG8_SP2
#define PG8_SP2 false
#endif
#ifndef DBG_QKV
#define DBG_QKV(...) __VA_ARGS__
#endif
#ifndef DBG_G1
#define DBG_G1(...) __VA_ARGS__
#endif
#ifndef DBG_WO
#define DBG_WO(...) __VA_ARGS__
#endif
#ifndef DBG_M1
#define DBG_M1(...) __VA_ARGS__
#endif
#ifndef DBG_M2
#define DBG_M2(...) __VA_ARGS__
#endif
#ifndef DBG_ATTN
#define DBG_ATTN(x) x
#endif
#ifndef DBG_G2B
#define DBG_G2B(x) x
#endif
#ifndef DBG_RT
#define DBG_RT(x) x
#endif
#ifndef DBG_P0
#define DBG_P0(x) x
#endif
#define MKFRAME() \
        unsigned char* ws; \
        { unsigned long long w = (unsigned long long)args.ws; unsigned wl = (unsigned)w, wh = (unsigned)(w >> 32); \
          asm volatile("" : "+v"(wl), "+v"(wh)); \
          wl = __builtin_amdgcn_readfirstlane(wl); wh = __builtin_amdgcn_readfirstlane(wh); \
          ws = (unsigned char*)(((unsigned long long)wh << 32) | wl); } \
        int tid_ = threadIdx.x; asm volatile("" : "+v"(tid_)); \
        Frame F; \
        F.lds = (LAS unsigned char*)lds; \
        F.MISC = (volatile LAS unsigned*)(F.lds + MISC_OFF); \
        F.tid = tid_; F.lane = F.tid & 63; F.wave = __builtin_amdgcn_readfirstlane(F.tid >> 6); \
        F.G = gridDim.x; { const int bx = blockIdx.x; F.vcu = (F.G % 8 == 0) ? (bx % 8) * (F.G / 8) + bx / 8 : bx; } \
        F.ws = ws; F.out = args.out; \
        F.ctl = (gu32*)(ws + WS_CTL); \
        F.XN = (bf16*)(ws + WS_XN); F.QO = (bf16*)(ws + WS_QO); F.KB = (bf16*)(ws + WS_K); F.VB = (bf16*)(ws + WS_V); F.UB = (bf16*)(ws + WS_U); F.VVB = (bf16*)(ws + WS_VV); \
        F.HB = (bf16*)(ws + WS_HB); F.YB = (bf16*)(ws + WS_YB);
__global__ void __launch_bounds__(NWAVES * 64, 2) fwd_kernel(Args args) {
    extern __shared__ __attribute__((aligned(16))) unsigned char lds[];
    for (int u = threadIdx.x; u < (LDS_BYTES - LDSCTL_OFF) / 4; u += NWAVES * 64) ((LAS unsigned*)((LAS unsigned char*)lds + LDSCTL_OFF))[u] = 0u;
    __syncthreads();
    const int lo = args.ph_lo, hi = args.ph_hi;
    XcdBarrier bar; bar.bar = (unsigned*)(args.ws + WS_CTL) + CW_BAR; bar.x = 0; bar.st = nullptr;
    if (hi - lo > 1) bar = xcd_barrier_post((unsigned*)(args.ws + WS_CTL) + CW_BAR, (volatile LAS unsigned*)((LAS unsigned char*)lds + MISC_OFF) + 8);
    for (int pk = lo; pk < hi; ++pk) {
        int kind = 0, l = 0;
        if (pk > 0) { const int p = pk - 1, pair = p / 17, r = p % 17;
            if (r < 8) { l = 2 * pair; kind = (r == 0) ? 1 : (r == 1) ? 2 : r + 4; }
            else { l = 2 * pair + 1; kind = (r - 8) + 3; } }
        const int j = l >> 1;
        if (kind == 0) { MKFRAME(); DBG_P0(p0_prologue(F, args)); }
        else if (kind == 1) { MKFRAME(); pg8::Gemm g{F.XN, (const bf16*)(ws + WS_WQKV) + (size_t)j * NQKV * D, M, NQKV, D, nullptr}; pg8::StaticOrder S; S.init(M, NQKV, F.G, (int)blockIdx.x);
            pg8::EpiBf16<0, 1> E{F.QO, D, nullptr, D, (size_t)(WS_K - WS_QO) / 2, QSCALE, (float*)(ws + WS_KSUM)};
            DBG_QKV(pg8::gemm_phase<pg8::EpiBf16<0, 1>, pg8::StaticOrder, true, PG8_SP2, false>(F.lds + RING_OFF, g, S, E, F.tid)); }
        else if (kind == 2) { MKFRAME(); DBG_ATTN(attn_naive_phase(F)); }
        else if (kind == 3) { MKFRAME(); pg8::Gemm g{F.XN, (const bf16*)(ws + WS_WIN) + (size_t)j * NZ * D, M, NZ, D, nullptr}; pg8::StaticOrder S; S.init(M, NZ, F.G, (int)blockIdx.x);
            pg8::EpiBf16<1, 2> E{F.UB, DV, args.in[4] + (size_t)j * NZ, DV, (size_t)(WS_VV - WS_U) / 2, 1.0f, (float*)(ws + WS_VPART)};
            DBG_G1(pg8::gemm_phase<pg8::EpiBf16<1, 2>, pg8::StaticOrder, true, PG8_SP2, false>(F.lds + RING_OFF, g, S, E, F.tid)); }
        else if (kind == 4) { MKFRAME(); g2a_phase(F); }
        else if (kind == 5) { MKFRAME(); DBG_G2B(g2b_naive_phase(F, args, j)); }
        else if (kind == 6) { MKFRAME(); pg8::Gemm g; if ((l & 1) == 0) g = pg8::Gemm{F.QO, (const bf16*)(ws + WS_WO) + (size_t)j * D * D, M, D, D, nullptr}; else g = pg8::Gemm{F.UB, (const bf16*)(ws + WS_WOUT) + (size_t)j * D * DV, M, D, DV, nullptr};
            pg8::StaticOrder S; S.init(M, D, F.G, (int)blockIdx.x);
            pg8::EpiBf16<0, 0> E{F.YB, D, nullptr, 0, 0, 1.0f, nullptr};
            DBG_WO(pg8::gemm_phase<pg8::EpiBf16<0, 0>, pg8::StaticOrder, true, PG8_SP2, false>(F.lds + RING_OFF, g, S, E, F.tid)); }
        else if (kind == 7) { MKFRAME(); resln_phase(F, F.YB, args.in[10] + (size_t)l * D, args.in[11] + (size_t)l * D); }
        else if (kind == 8) { MKFRAME(); DBG_RT(router_phase(F, args, l)); }
        else if (kind == 9) { MKFRAME(); const int ntiles = moe_tables(F, l); const LAS int* tb = (const LAS int*)(F.lds + TAB_OFF);
            pg8::Gemm g{F.XN, (const bf16*)(ws + WS_W13) + (size_t)l * NE * 512 * D, M, 512, D, (const int*)(ws + WS_TOK)};
            MoeOrder S{ntiles, 2, F.G, F.vcu, tb, tb + 64, tb + 64 + 68};
            pg8::EpiMoe1 E{F.HB};
            DBG_M1(pg8::gemm_phase<pg8::EpiMoe1, MoeOrder, true, PG8_SP2, true>(F.lds + RING_OFF, g, S, E, F.tid)); }
        else if (kind == 10) { MKFRAME(); const int ntiles = moe_tables(F, l); const LAS int* tb = (const LAS int*)(F.lds + TAB_OFF);
            pg8::Gemm g{F.HB, (const bf16*)(ws + WS_W2) + (size_t)l * NE * D * FE, MAXTILES * 256, D, FE, nullptr};
            MoeOrder S{ntiles, 4, F.G, F.vcu, tb, tb + 64, tb + 64 + 68};
            pg8::EpiBf16<0, 0> E{F.YB, D, nullptr, 0, 0, 1.0f, nullptr};
            DBG_M2(pg8::gemm_phase<pg8::EpiBf16<0, 0>, MoeOrder, true, PG8_SP2, false>(F.lds + RING_OFF, g, S, E, F.tid)); }
        else { MKFRAME(); (void)moe_tables(F, l); combine_phase(F, l, args.in[12] + (size_t)l * D, args.in[13] + (size_t)l * D, l == DEPTH - 1); }
        if (pk + 1 < hi) xcd_barrier(bar);
    }
}

extern "C" void kernel_launch(void* const* d_in, const int* in_sizes, int n_in, void* d_out, int out_size, void* d_ws, size_t ws_size, hipStream_t stream) {
    static int grid = 0;
    if (grid == 0) {
        if (n_in != 21 || in_sizes[0] != M * D || out_size != M * D || ws_size < WS_END) { fprintf(stderr, "kernel_launch: unexpected shapes (n_in %d, in0 %d, out %d, ws %zu); nothing launched\n", n_in, n_in > 0 ? in_sizes[0] : -1, out_size, ws_size); grid = -1; return; }
        int dev = 0, cus = 0, per_cu = 0;
        if (hipGetDevice(&dev) != hipSuccess || hipDeviceGetAttribute(&cus, hipDeviceAttributeMultiprocessorCount, dev) != hipSuccess) { fprintf(stderr, "kernel_launch: device query failed\n"); grid = -1; return; }
        if (hipFuncSetAttribute((const void*)fwd_kernel, hipFuncAttributeMaxDynamicSharedMemorySize, LDS_BYTES) != hipSuccess) { fprintf(stderr, "kernel_launch: hipFuncSetAttribute failed\n"); grid = -1; return; }
        if (hipOccupancyMaxActiveBlocksPerMultiprocessor(&per_cu, (const void*)fwd_kernel, NWAVES * 64, LDS_BYTES) != hipSuccess || per_cu < 1)
            fprintf(stderr, "kernel_launch: note: occupancy query reports %d workgroups per CU\n", per_cu);
        (void)hipGetLastError();
        grid = cus;
        if (grid != 256) fprintf(stderr, "kernel_launch: %d CUs; this build expects 256\n", grid);
    }
    if (grid < 0) return;
    if (hipMemsetAsync((char*)d_ws + WS_CTL, 0, CTL_ZERO_BYTES, stream) != hipSuccess) { fprintf(stderr, "kernel_launch: hipMemsetAsync failed\n"); return; }
    Args a{};
    for (int i = 0; i < 21; ++i) a.in[i] = (const float*)d_in[i];
    a.out = (float*)d_out; a.ws = (unsigned char*)d_ws;
    constexpr int NL = MK_N_LAUNCHES;
    for (int li = 0; li < NL; ++li) {
        if (NL == 1) { a.ph_lo = 0; a.ph_hi = NPHASES; } else { a.ph_lo = li; a.ph_hi = li + 1; }
        hipLaunchKernelGGL(fwd_kernel, dim3(grid), dim3(NWAVES * 64), LDS_BYTES, stream, a);
        const hipError_t le = hipPeekAtLastError();
        if (le != hipSuccess) { fprintf(stderr, "kernel_launch: launch %d failed: %s\n", li, hipGetErrorName(le)); break; }
    }
}
```

```cpp
#include <hip/hip_runtime.h>
#include <hip/hip_bf16.h>
#include <cstdio>
#include <cstdint>
#include <cmath>
namespace pg8 {
#define PG8_LAS __attribute__((address_space(3)))
typedef unsigned short bf16_t;
typedef short bf16x8 __attribute__((ext_vector_type(8)));
typedef float f32x4 __attribute__((ext_vector_type(4)));
typedef unsigned u32x4 __attribute__((ext_vector_type(4)));
typedef unsigned u32x2 __attribute__((ext_vector_type(2)));
constexpr int BM = 256, BK = 64, HALF = 128, HTB = HALF * BK * 2  , STAGE_BYTES = 8 * HTB, NXCD = 8, WGM = 8;

__host__ __device__ __forceinline__ int lds_byte(int r, int c) { const int st = (r >> 4) * 2 + (c >> 5), rr = r & 15, cc = c & 31, ob = rr * 64 + cc * 2; return st * 1024 + (ob ^ (((ob >> 9) & 1) << 5)); }
__host__ __device__ __forceinline__ void stage_rc(int b, int& R, int& C) { const int st = b / 1024, sb = b % 1024, swz = sb ^ (((sb >> 9) & 1) << 5); R = (st >> 1) * 16 + swz / 64; C = (st & 1) * 32 + (swz % 64) / 2; }
__host__ __device__ __forceinline__ int perm32(int rho) { const int n = rho >> 4, i = rho & 15; return 8 * (i >> 2) + 4 * n + (i & 3); }

struct Unit { int pm, pn, pb, gofs, gcnt; };
struct Gemm { const bf16_t* A; const bf16_t* Bt; int M, N, K; const int* rows; };

struct StaticOrder {
    int nM, nN, nwg, G, c;
    __host__ __device__ void init(int M, int N, int G_, int c_) { nM = M / BM; nN = N / BM; nwg = nM * nN; G = G_; c = c_; }
    __host__ __device__ bool next(int i, Unit& u) const {
        const long L = (long)i * G + c; if (L >= nwg) return false;
        int wgid = (int)L; { const int q = nwg / NXCD, r = nwg % NXCD, xcd = wgid % NXCD, off = wgid / NXCD; wgid = (xcd < r ? xcd * (q + 1) : r * (q + 1) + (xcd - r) * q) + off; }
        const int nig = WGM * nN, gid = wgid / nig, fm = gid * WGM, gsz = (nM - fm) < WGM ? (nM - fm) : WGM;
        u.pm = fm + ((wgid % nig) % gsz); u.pn = (wgid % nig) / gsz; u.pb = u.pn; u.gofs = 0; u.gcnt = 0; return true;
    }
};

__device__ __forceinline__ unsigned cvt_pk_bf16(float lo, float hi) { unsigned r; asm volatile("v_cvt_pk_bf16_f32 %0, %1, %2" : "=v"(r) : "v"(lo), "v"(hi)); return r; }
typedef float f32x2 __attribute__((ext_vector_type(2)));
__device__ __forceinline__ f32x2 gelu_pk(f32x2 v) {
    const f32x2 av = __builtin_elementwise_abs(v), d = av * 0.2316418882f + 1.0f;
    f32x2 t; t.x = __builtin_amdgcn_rcpf(d.x); t.y = __builtin_amdgcn_rcpf(d.y);
    f32x2 q = t * 0.5307027145f + (-0.7265760135f); q = q * t + 0.7107068705f; q = q * t + (-0.142248368f); q = q * t + 0.127414796f; q = q * t;
    const f32x2 s = (v * v) * (-0.72134752044f);
    f32x2 e; e.x = __builtin_amdgcn_exp2f(s.x); e.y = __builtin_amdgcn_exp2f(s.y);
    const f32x2 m = v * (q * e), r = v - m;
    f32x2 o; o.x = v.x < 0.f ? m.x : r.x; o.y = v.y < 0.f ? m.y : r.y; return o;
}

template <int ACT, int EXTRA> struct EpiBf16 {
    static constexpr bool PERM = true, AFTER_DRAIN = false; static_assert(ACT == 0 || ACT == 1, "EpiBf16: ACT is 0 (none) or 1 (gelu_pk)");
    bf16_t* O; int ldc; const float* bias; int split_cols; size_t split_stride; float scale0; float* xtra;
    __device__ __forceinline__ void operator()(const f32x4 (&acc)[2][2][4][2], const Unit& u, int wr, int wc, int fr, int fq) const {
        const int row0 = u.pm * BM + wr * 64 + fr; int colt = u.pn * BM; bf16_t* base = O;
        float sc = 1.f; if (split_cols) { const int t = colt / split_cols; base += (size_t)t * split_stride; colt -= t * split_cols; if (t == 0) sc = scale0; }
        const int col0 = colt + wc * 32 + 8 * fq, bcol0 = u.pn * BM + wc * 32 + 8 * fq;
        f32x4 bv[2][2];
#pragma unroll
        for (int bj = 0; bj < 2; ++bj)
#pragma unroll
            for (int n = 0; n < 2; ++n) bv[bj][n] = bias ? *(const f32x4*)(bias + bcol0 + bj * HALF + 4 * n) : (f32x4){0.f, 0.f, 0.f, 0.f};
        f32x4 cs[2][2];
        if (EXTRA == 1) {
#pragma unroll
            for (int bj = 0; bj < 2; ++bj)
#pragma unroll
                for (int n = 0; n < 2; ++n) cs[bj][n] = (f32x4){0.f, 0.f, 0.f, 0.f};
        }
        const bool vt = (EXTRA == 2) && (u.pn >= 12);
#pragma unroll
        for (int ai = 0; ai < 2; ++ai)
#pragma unroll
            for (int m = 0; m < 4; ++m) { bf16_t* rowp = base + (size_t)(row0 + ai * HALF + m * 16) * ldc + col0;
                float s1 = 0.f, s2 = 0.f;
#pragma unroll
                for (int bj = 0; bj < 2; ++bj) { f32x4 v0 = acc[ai][bj][m][0] + bv[bj][0], v1 = acc[ai][bj][m][1] + bv[bj][1];
                    if (ACT == 1) { f32x2 a = gelu_pk((f32x2){v0[0], v0[1]}), b = gelu_pk((f32x2){v0[2], v0[3]}), c = gelu_pk((f32x2){v1[0], v1[1]}), d = gelu_pk((f32x2){v1[2], v1[3]});
                        v0 = (f32x4){a.x, a.y, b.x, b.y}; v1 = (f32x4){c.x, c.y, d.x, d.y}; }
                    if (EXTRA == 1) { cs[bj][0] += v0; cs[bj][1] += v1; }
                    if (EXTRA == 2) { s1 += ((v0[0] + v0[1]) + (v0[2] + v0[3])) + ((v1[0] + v1[1]) + (v1[2] + v1[3]));
                                      s2 += ((v0[0] * v0[0] + v0[1] * v0[1]) + (v0[2] * v0[2] + v0[3] * v0[3])) + ((v1[0] * v1[0] + v1[1] * v1[1]) + (v1[2] * v1[2] + v1[3] * v1[3])); }
                    v0 = v0 * sc; v1 = v1 * sc; u32x4 w; w.x = cvt_pk_bf16(v0[0], v0[1]); w.y = cvt_pk_bf16(v0[2], v0[3]); w.z = cvt_pk_bf16(v1[0], v1[1]); w.w = cvt_pk_bf16(v1[2], v1[3]);
                    *(u32x4*)(rowp + bj * HALF) = w; }
                if (EXTRA == 2) { if (vt) { s1 += __shfl_xor(s1, 16); s1 += __shfl_xor(s1, 32); s2 += __shfl_xor(s2, 16); s2 += __shfl_xor(s2, 32);
                    if (fq == 0) *(f32x2*)(xtra + ((size_t)(row0 + ai * HALF + m * 16) * 48 + (u.pn - 12) * 4 + wc) * 2) = (f32x2){s1, s2}; } }
            }
        if (EXTRA == 1) { if (u.pn >= 4 && u.pn < 8) {
#pragma unroll
            for (int bj = 0; bj < 2; ++bj)
#pragma unroll
                for (int n = 0; n < 2; ++n) { f32x4 s = cs[bj][n];
#pragma unroll
                    for (int o = 1; o < 16; o <<= 1) { s[0] += __shfl_xor(s[0], o); s[1] += __shfl_xor(s[1], o); s[2] += __shfl_xor(s[2], o); s[3] += __shfl_xor(s[3], o); }
                    if (fr == 0) *(f32x4*)(xtra + ((size_t)wr * (16384 / 256) + u.pm) * 1024 + (u.pn - 4) * BM + bj * HALF + wc * 32 + 8 * fq + 4 * n) = s; } } }
    }
};

struct EpiMoe1 {
    static constexpr bool PERM = true, AFTER_DRAIN = false;
    bf16_t* Hb;
    __device__ __forceinline__ void operator()(const f32x4 (&acc)[2][2][4][2], const Unit& u, int wr, int wc, int fr, int fq) const {
        const int row0 = u.pm * BM + wr * 64 + fr, col0 = u.pn * HALF + wc * 32 + 8 * fq;
#pragma unroll
        for (int ai = 0; ai < 2; ++ai)
#pragma unroll
            for (int m = 0; m < 4; ++m) { bf16_t* rowp = Hb + (size_t)(row0 + ai * HALF + m * 16) * 256 + col0; float h[8];
#pragma unroll
                for (int n = 0; n < 2; ++n)
#pragma unroll
                    for (int j = 0; j < 4; ++j) { const float g = acc[ai][0][m][n][j], up = acc[ai][1][m][n][j];
                        h[n * 4 + j] = g * __builtin_amdgcn_rcpf(1.0f + __builtin_amdgcn_exp2f(-1.4426950408889634f * g)) * up; }
                u32x4 w; w.x = cvt_pk_bf16(h[0], h[1]); w.y = cvt_pk_bf16(h[2], h[3]); w.z = cvt_pk_bf16(h[4], h[5]); w.w = cvt_pk_bf16(h[6], h[7]);
                *(u32x4*)rowp = w; }
    }
};

struct PanelStats {
    unsigned* xbuf;
    unsigned* cnt;
    unsigned* tmo;
    int ntn; float eps; unsigned code;
    __device__ __forceinline__ bool run(const f32x4 (&v)[2][2][4][2], const Unit& u, int wr, int wc, int fr, int fq, PG8_LAS unsigned char* lds, int wid, int lane) const {
        typedef float f32x2v __attribute__((ext_vector_type(2)));
        PG8_LAS f32x2v* P = (PG8_LAS f32x2v*)lds;
        PG8_LAS f32x2v* S = (PG8_LAS f32x2v*)(lds + 8192);
        PG8_LAS unsigned* flag = (PG8_LAS unsigned*)(lds + 8192 + 2048);
#pragma unroll
        for (int ai = 0; ai < 2; ++ai)
#pragma unroll
            for (int m = 0; m < 4; ++m) {
                float s = 0.f;
#pragma unroll
                for (int bj = 0; bj < 2; ++bj)
#pragma unroll
                    for (int n = 0; n < 2; ++n) { const f32x4 x = v[ai][bj][m][n]; s += (x[0] + x[1]) + (x[2] + x[3]); }
                s += __shfl_xor(s, 16); s += __shfl_xor(s, 32);
                const float mw = s * (1.0f / 64.0f); float q = 0.f;
#pragma unroll
                for (int bj = 0; bj < 2; ++bj)
#pragma unroll
                    for (int n = 0; n < 2; ++n) { const f32x4 d = v[ai][bj][m][n] - mw; q += (d[0] * d[0] + d[1] * d[1]) + (d[2] * d[2] + d[3] * d[3]); }
                q += __shfl_xor(q, 16); q += __shfl_xor(q, 32);
                if (fq == 0) P[(ai * HALF + wr * 64 + m * 16 + fr) * 4 + wc] = (f32x2v){mw, q};
            }
        asm volatile("s_waitcnt lgkmcnt(0)" ::: "memory"); __builtin_amdgcn_s_barrier(); asm volatile("" ::: "memory");
        const int row = wid * 32 + (lane & 31);
        if (lane < 32) {
            const f32x2v a = P[row * 4 + 0], b = P[row * 4 + 1], c = P[row * 4 + 2], d = P[row * 4 + 3];
            const float mt = (a.x + b.x + c.x + d.x) * 0.25f;
            const float da = a.x - mt, db = b.x - mt, dc = c.x - mt, dd = d.x - mt;
            const float m2 = (a.y + b.y) + (c.y + d.y) + 64.0f * ((da * da + db * db) + (dc * dc + dd * dd));
            unsigned long long* slot = (unsigned long long*)xbuf + ((size_t)(u.pm * BM + row) * 4 + u.pn);
            __hip_atomic_store(slot, ((unsigned long long)__float_as_uint(m2) << 32) | __float_as_uint(mt), __ATOMIC_RELAXED, __HIP_MEMORY_SCOPE_AGENT);
        }
        asm volatile("s_waitcnt vmcnt(0)" ::: "memory");
        if (lane == 0) __hip_atomic_fetch_add(cnt + 64 * u.pm, 1u, __ATOMIC_RELAXED, __HIP_MEMORY_SCOPE_AGENT);
        if (wid == 0) {
            bool dead = false; const unsigned long long t0 = __builtin_amdgcn_s_memrealtime(); const unsigned want = 8u * (unsigned)ntn;
            for (;;) {
                if ((unsigned)__builtin_amdgcn_readfirstlane(__hip_atomic_load(cnt + 64 * u.pm, __ATOMIC_RELAXED, __HIP_MEMORY_SCOPE_AGENT)) >= want) break;
                if (__builtin_amdgcn_s_memrealtime() - t0 > 2000000ull) {
                    if (lane == 0) { unsigned expect = 0u; __hip_atomic_compare_exchange_strong(tmo + 1, &expect, code | (unsigned)(u.pm & 0xff), __ATOMIC_RELAXED, __ATOMIC_RELAXED, __HIP_MEMORY_SCOPE_AGENT);
                                     __hip_atomic_store(tmo, 1u, __ATOMIC_RELAXED, __HIP_MEMORY_SCOPE_AGENT); }
                    dead = true; break; }
                __builtin_amdgcn_s_sleep(2);
            }
            __builtin_amdgcn_fence(__ATOMIC_ACQUIRE, "agent");
            if (lane == 0) flag[0] = dead ? 1u : 0u;
        }
        asm volatile("s_waitcnt vmcnt(0) lgkmcnt(0)" ::: "memory"); __builtin_amdgcn_s_barrier(); asm volatile("" ::: "memory");
        const bool bad = flag[0] != 0u;
        if (lane < 32) {
            const unsigned long long* slot = (const unsigned long long*)xbuf + (size_t)(u.pm * BM + row) * 4; float mt[4], m2[4]; float ms = 0.f;
#pragma unroll
            for (int t = 0; t < 4; ++t) { if (t < ntn) { const unsigned long long w = __hip_atomic_load(slot + t, __ATOMIC_RELAXED, __HIP_MEMORY_SCOPE_AGENT); mt[t] = __uint_as_float((unsigned)w); m2[t] = __uint_as_float((unsigned)(w >> 32)); } else { mt[t] = 0.f; m2[t] = 0.f; } ms += mt[t]; }
            const float mean = ms / (float)ntn; float q = 0.f;
#pragma unroll
            for (int t = 0; t < 4; ++t) if (t < ntn) { const float dm = mt[t] - mean; q += m2[t] + 256.0f * dm * dm; }
            S[row] = (f32x2v){mean, 1.0f / sqrtf(q / (256.0f * (float)ntn) + eps)};
        }
        asm volatile("s_waitcnt lgkmcnt(0)" ::: "memory"); __builtin_amdgcn_s_barrier(); asm volatile("" ::: "memory");
        return bad;
    }
};
struct EpiLn1 {
    static constexpr bool PERM = false, AFTER_DRAIN = true;
    bf16_t* X; const float* gamma; const float* beta; float alpha; PanelStats st;
    __device__ __forceinline__ void fused(f32x4 (&acc)[2][2][4][2], const Unit& u, int wr, int wc, int fr, int fq, PG8_LAS unsigned char* lds, int wid, int lane) const {
        typedef float f32x2v __attribute__((ext_vector_type(2)));
        const PG8_LAS f32x2v* S = (const PG8_LAS f32x2v*)(lds + 8192);
        const int col0 = u.pn * BM + wc * 32 + 4 * fq;
#pragma unroll
        for (int ai = 0; ai < 2; ++ai)
#pragma unroll
            for (int m = 0; m < 4; ++m) { const size_t off = (size_t)(u.pm * BM + ai * HALF + wr * 64 + m * 16 + fr) * 1024 + col0;
#pragma unroll
                for (int bj = 0; bj < 2; ++bj)
#pragma unroll
                    for (int n = 0; n < 2; ++n) { const u32x2 b = *(const u32x2*)(X + off + bj * HALF + n * 16);
                        const f32x4 bs = (f32x4){__uint_as_float(b.x << 16), __uint_as_float(b.x & 0xffff0000u), __uint_as_float(b.y << 16), __uint_as_float(b.y & 0xffff0000u)};
                        acc[ai][bj][m][n] += bs * alpha; }
                if (m & 1) asm volatile("" ::: "memory"); }
        (void)st.run(acc, u, wr, wc, fr, fq, lds, wid, lane);
        f32x4 gv[2][2], bv[2][2];
#pragma unroll
        for (int bj = 0; bj < 2; ++bj)
#pragma unroll
            for (int n = 0; n < 2; ++n) { gv[bj][n] = *(const f32x4*)(gamma + col0 + bj * HALF + n * 16); bv[bj][n] = *(const f32x4*)(beta + col0 + bj * HALF + n * 16); }
#pragma unroll
        for (int ai = 0; ai < 2; ++ai)
#pragma unroll
            for (int m = 0; m < 4; ++m) { const int r = ai * HALF + wr * 64 + m * 16 + fr; const f32x2v sr = S[r]; const size_t off = (size_t)(u.pm * BM + r) * 1024 + col0;
#pragma unroll
                for (int bj = 0; bj < 2; ++bj)
#pragma unroll
                    for (int n = 0; n < 2; ++n) { const f32x4 o = (acc[ai][bj][m][n] - sr.x) * sr.y * gv[bj][n] + bv[bj][n];
                        u32x2 w; w.x = cvt_pk_bf16(o[0], o[1]); w.y = cvt_pk_bf16(o[2], o[3]); *(u32x2*)(X + off + bj * HALF + n * 16) = w; } }
    }
};

template <class Epi, class Sched, bool ALIGN_EPI = false, bool SP2 = false, bool GATHER = false>
__device__ __forceinline__ void gemm_phase(PG8_LAS unsigned char* lds, const Gemm g, const Sched& S, const Epi& E, const int tid) {
    const int wid = __builtin_amdgcn_readfirstlane(tid >> 6), lane = tid & 63, wr = wid >> 2, wc = wid & 3, fr = lane & 15, fq = lane >> 4;
    const int K = g.K, nt = K / BK;
    unsigned voffA[2], voffB[2]; int gR[2], gC[2];
#pragma unroll
    for (int i = 0; i < 2; ++i) { int R, C; stage_rc(tid * 16 + i * 8192, R, C); const int Rb = Epi::PERM ? ((R & ~31) + perm32(R & 31)) : R;
        voffA[i] = (unsigned)(R * K + C) * 2u; voffB[i] = (unsigned)(Rb * K + C) * 2u; gR[i] = R; gC[i] = C; }
    const size_t kstep = (size_t)(BK * 2);
    const size_t hstep = (size_t)HALF * K * 2;
    const size_t tstep = 2 * hstep;
    const unsigned ldsw = (unsigned)wid * 1024u;
    const int aoff = lds_byte(wr * 64 + fr, fq * 8), boff = lds_byte(wc * 32 + fr, fq * 8);
    unsigned voA[2][2], voAn[2][2];
#define PG8_GOFF(vo, uu) do { if constexpr (GATHER) { _Pragma("unroll") for (int _h = 0; _h < 2; ++_h) _Pragma("unroll") for (int _i = 0; _i < 2; ++_i) { \
        const int _r = _h * HALF + gR[_i]; int _tk = 0; if (_r < (uu).gcnt) _tk = g.rows[(uu).gofs + _r]; (vo)[_h][_i] = (unsigned)(_tk * K + gC[_i]) * 2u; } } } while (0)
#define PG8_SA(b, h) (((b) * 2 + (h)) * HTB)
#define PG8_SB(b, h) ((4 + (b) * 2 + (h)) * HTB)
#define PG8_STAGE(bufoff, gbase, voff) do { _Pragma("unroll") for (int _i = 0; _i < 2; ++_i) \
        __builtin_amdgcn_global_load_lds((const unsigned*)((const char*)(gbase) + (voff)[_i]), (PG8_LAS unsigned*)(lds + (bufoff) + ldsw + _i * 8192), 16, 0, 0); } while (0)
#define PG8_STA(b, h, kp, NX) do { if constexpr (GATHER) { unsigned _o[2]; _o[0] = (NX) ? voAn[h][0] : voA[h][0]; _o[1] = (NX) ? voAn[h][1] : voA[h][1]; PG8_STAGE(PG8_SA(b, h), (kp), _o); } \
        else { PG8_STAGE(PG8_SA(b, h), (kp) + (h) * hstep, voffA); } } while (0)
#define PG8_LDA(dst, b, h) do { _Pragma("unroll") for (int m = 0; m < 4; ++m) _Pragma("unroll") for (int k = 0; k < 2; ++k) dst[m][k] = *(const PG8_LAS bf16x8*)(lds + PG8_SA(b, h) + aoff + m * 2048 + k * 1024); } while (0)
#define PG8_LDB(dst, b, h) do { _Pragma("unroll") for (int n = 0; n < 2; ++n) _Pragma("unroll") for (int k = 0; k < 2; ++k) dst[n][k] = *(const PG8_LAS bf16x8*)(lds + PG8_SB(b, h) + boff + n * 2048 + k * 1024); } while (0)
#define PG8_MMA(ai, bj, At, Bt) do { __builtin_amdgcn_s_setprio(1); _Pragma("unroll") for (int m = 0; m < 4; ++m) _Pragma("unroll") for (int n = 0; n < 2; ++n) _Pragma("unroll") for (int k = 0; k < 2; ++k) \
        acc[ai][bj][m][n] = __builtin_amdgcn_mfma_f32_16x16x32_bf16(Bt[n][k], At[m][k], acc[ai][bj][m][n], 0, 0, 0); __builtin_amdgcn_s_setprio(0); } while (0)
#define PG8_WAIT_V(n) asm volatile("s_waitcnt vmcnt(" #n ")" ::: "memory")
#define PG8_WAIT_L(n) asm volatile("s_waitcnt lgkmcnt(" #n ")" ::: "memory")
#define PG8_BAR __builtin_amdgcn_s_barrier()
#define PG8_SCHED __builtin_amdgcn_sched_barrier(0)
    Unit cur, nxt; int ui = 0;
    if (!S.next(0, cur)) return;
    f32x4 acc[2][2][4][2];
#pragma unroll
    for (int a = 0; a < 2; ++a)
#pragma unroll
        for (int b = 0; b < 2; ++b)
#pragma unroll
            for (int m = 0; m < 4; ++m)
#pragma unroll
                for (int n = 0; n < 2; ++n) acc[a][b][m][n] = (f32x4){0.f, 0.f, 0.f, 0.f};
    bf16x8 At[4][2], B0[2][2], B1[2][2];
    const char* cA = GATHER ? (const char*)g.A : (const char*)g.A + (size_t)cur.pm * tstep; const char* cB = (const char*)g.Bt + (size_t)cur.pb * tstep;
    PG8_GOFF(voA, cur);
    if constexpr (GATHER) { _Pragma("unroll") for (int _h = 0; _h < 2; ++_h) _Pragma("unroll") for (int _i = 0; _i < 2; ++_i) voAn[_h][_i] = voA[_h][_i]; }
    if constexpr (SP2) {
        PG8_STAGE(PG8_SB(0, 0), cB, voffB); PG8_STAGE(PG8_SB(0, 1), cB + hstep, voffB); PG8_STA(0, 0, cA, false); PG8_STA(0, 1, cA, false);
        if (wr == 1) PG8_BAR;
        PG8_WAIT_V(2); PG8_BAR;
        PG8_STAGE(PG8_SB(1, 0), cB + kstep, voffB); PG8_STA(1, 0, cA + kstep, false); PG8_STAGE(PG8_SB(1, 1), cB + hstep + kstep, voffB);
        PG8_WAIT_V(6); PG8_BAR;
    } else {
        PG8_STAGE(PG8_SB(0, 0), cB, voffB); PG8_STA(0, 0, cA, false); PG8_STAGE(PG8_SB(0, 1), cB + hstep, voffB); PG8_STA(0, 1, cA, false);
        if (wr == 1) PG8_BAR;
        PG8_WAIT_V(4); PG8_BAR;
        PG8_STAGE(PG8_SB(1, 0), cB + kstep, voffB); PG8_STA(1, 0, cA + kstep, false); PG8_STAGE(PG8_SB(1, 1), cB + hstep + kstep, voffB);
        PG8_WAIT_V(6); PG8_BAR;
    }
    for (;;) {
        const bool has_next = S.next(ui + 1, nxt);
        if constexpr (GATHER) { if (has_next) { PG8_GOFF(voAn, nxt); asm volatile("s_waitcnt vmcnt(0)" ::: "memory"); } }
        const char* nA = GATHER ? cA : (has_next ? (const char*)g.A + (size_t)nxt.pm * tstep : cA); const char* nB = has_next ? (const char*)g.Bt + (size_t)nxt.pb * tstep : cB;
        for (int t = 0; t < nt; t += 2) {
            const bool last = (t == nt - 2);
            const bool NX = last && has_next;
            const char* a1 = cA + (size_t)(t + 1) * kstep;
            const char* a2 = last ? nA : cA + (size_t)(t + 2) * kstep; const char* b2 = last ? nB : cB + (size_t)(t + 2) * kstep;
            const char* a3 = a2 + kstep; const char* b3 = b2 + kstep;
            if constexpr (SP2) {
            PG8_LDB(B0, 0, 0); PG8_LDB(B1, 0, 1); PG8_SCHED; PG8_LDA(At, 0, 0); PG8_STA(1, 1, a1, false);
            PG8_WAIT_V(8); PG8_WAIT_L(0); PG8_BAR; PG8_MMA(0, 0, At, B0); PG8_MMA(0, 1, At, B1); PG8_BAR; PG8_SCHED;
            PG8_LDA(At, 0, 1); PG8_STAGE(PG8_SB(0, 0), b2, voffB); PG8_STAGE(PG8_SB(0, 1), b2 + hstep, voffB); PG8_STA(0, 0, a2, NX);
            PG8_WAIT_V(8); PG8_WAIT_L(0); PG8_BAR; PG8_MMA(1, 0, At, B0); PG8_MMA(1, 1, At, B1); PG8_BAR; PG8_SCHED;
            PG8_LDB(B0, 1, 0); PG8_LDB(B1, 1, 1); PG8_SCHED; PG8_LDA(At, 1, 0); PG8_STA(0, 1, a2, NX);
            PG8_WAIT_V(8); PG8_WAIT_L(0); PG8_BAR; PG8_MMA(0, 0, At, B0); PG8_MMA(0, 1, At, B1); PG8_BAR; PG8_SCHED;
            PG8_LDA(At, 1, 1); PG8_STAGE(PG8_SB(1, 0), b3, voffB); PG8_STAGE(PG8_SB(1, 1), b3 + hstep, voffB); PG8_STA(1, 0, a3, NX);
            PG8_WAIT_V(8); PG8_WAIT_L(0); PG8_BAR; PG8_MMA(1, 0, At, B0); PG8_MMA(1, 1, At, B1); PG8_BAR; PG8_SCHED;
            } else {
            PG8_LDB(B0, 0, 0); PG8_SCHED; PG8_LDA(At, 0, 0); PG8_STA(1, 1, a1, false);
            PG8_WAIT_L(8); PG8_BAR; PG8_WAIT_L(0); PG8_MMA(0, 0, At, B0); PG8_BAR; PG8_SCHED;
            PG8_LDB(B1, 0, 1); PG8_STAGE(PG8_SB(0, 0), b2, voffB);
            PG8_BAR; PG8_WAIT_L(0); PG8_MMA(0, 1, At, B1); PG8_BAR;
            PG8_LDA(At, 0, 1); PG8_STA(0, 0, a2, NX);
            PG8_BAR; PG8_WAIT_L(0); PG8_MMA(1, 0, At, B0); PG8_BAR; PG8_SCHED;
            PG8_STAGE(PG8_SB(0, 1), b2 + hstep, voffB);
            PG8_WAIT_V(6); PG8_BAR; PG8_MMA(1, 1, At, B1); PG8_BAR;
            PG8_LDB(B0, 1, 0); PG8_SCHED; PG8_LDA(At, 1, 0); PG8_STA(0, 1, a2, NX);
            PG8_WAIT_L(8); PG8_BAR; PG8_WAIT_L(0); PG8_MMA(0, 0, At, B0); PG8_BAR; PG8_SCHED;
            PG8_LDB(B1, 1, 1); PG8_STAGE(PG8_SB(1, 0), b3, voffB);
            PG8_BAR; PG8_WAIT_L(0); PG8_MMA(0, 1, At, B1); PG8_BAR;
            PG8_LDA(At, 1, 1); PG8_STA(1, 0, a3, NX);
            PG8_BAR; PG8_WAIT_L(0); PG8_MMA(1, 0, At, B0); PG8_BAR; PG8_SCHED;
            PG8_STAGE(PG8_SB(1, 1), b3 + hstep, voffB);
            PG8_WAIT_V(6); PG8_BAR; PG8_MMA(1, 1, At, B1); PG8_BAR;
            }
        }
        if constexpr (ALIGN_EPI) { if (wr == 0) PG8_BAR; }
        if constexpr (!Epi::AFTER_DRAIN) { int t2 = tid; asm volatile("" : "+v"(t2)); const int l2 = t2 & 63; E(acc, cur, wr, wc, l2 & 15, l2 >> 4); }
        if (!has_next) break;
#pragma unroll
        for (int a = 0; a < 2; ++a)
#pragma unroll
            for (int b = 0; b < 2; ++b)
#pragma unroll
                for (int m = 0; m < 4; ++m)
#pragma unroll
                    for (int n = 0; n < 2; ++n) acc[a][b][m][n] = (f32x4){0.f, 0.f, 0.f, 0.f};
        cur = nxt; cA = nA; cB = nB; ++ui;
        if constexpr (GATHER) { _Pragma("unroll") for (int _h = 0; _h < 2; ++_h) _Pragma("unroll") for (int _i = 0; _i < 2; ++_i) voA[_h][_i] = voAn[_h][_i]; }
        if constexpr (ALIGN_EPI) { if (wr == 1) PG8_BAR; }
    }
    PG8_WAIT_V(0);
    if constexpr (!ALIGN_EPI) { if (wr == 0) PG8_BAR; }
    PG8_BAR;
    if constexpr (Epi::AFTER_DRAIN) { int t2 = tid; asm volatile("" : "+v"(t2)); const int l2 = t2 & 63; E.fused(acc, cur, wr, wc, l2 & 15, l2 >> 4, lds, wid, l2); }
#undef PG8_GOFF
#undef PG8_SA
#undef PG8_SB
#undef PG8_STAGE
#undef PG8_STA
#undef PG8_LDA
#undef PG8_LDB
#undef PG8_MMA
#undef PG8_WAIT_V
#undef PG8_WAIT_L
#undef PG8_BAR
#undef PG8_SCHED
}
}
#include <hip/hip_bf16.h>
#include <cmath>
namespace attn_body {
using bf16=__hip_bfloat16;
using bf16x8=__attribute__((ext_vector_type(8)))short;
using s16x4=__attribute__((ext_vector_type(4)))short;
using f32x16=__attribute__((ext_vector_type(16)))float;
using u32x4=__attribute__((ext_vector_type(4)))unsigned;
constexpr int BATCH=8,NHEAD=16,SEQ=2048,D=64,DM=NHEAD*D;
constexpr int NW=8,QBLK=32,QB=QBLK*NW,KVBLK=64,NQB=SEQ/QB;
constexpr int ATTN_PITCH=DM, ATTN_UNIT_ROWS=QB; constexpr int LDS_KM=98304; constexpr float NEGBIG=-1e30f;
__device__ __forceinline__ int crow(int r,int hi){return (r&3)+8*(r>>2)+4*hi;}
#define SBAR() __builtin_amdgcn_sched_barrier(0)
__device__ __forceinline__ void cmask(f32x16&p0,f32x16&p1,int jb,int qrel,int hi){
  const float NEG=-INFINITY; int kb=64*jb+4*hi;
  #pragma unroll
  for(int r=0;r<16;++r){int kv=kb+(r&3)+8*(r>>2); if(kv>qrel)p0[r]=NEG; if(kv+32>qrel)p1[r]=NEG;}
}

typedef float f32x4_t __attribute__((ext_vector_type(4)));
__device__ __forceinline__ float bf2f_(short v){return __uint_as_float(((unsigned)(unsigned short)v)<<16);}
constexpr int NSLOT=3, SLOTB=8192;
constexpr int LDS_K=0, LDS_V=NSLOT*SLOTB, LDS_WS=2*NSLOT*SLOTB, LDS_OST=LDS_WS+NW*64*4, LDS_BYTES=LDS_OST+NW*4096;
constexpr float C2=0.125f*1.4426950408889634f;
__device__ __forceinline__ void glds16(const void*gsrc,unsigned lds_dst){unsigned keep;
  asm volatile("s_mov_b32 %0, m0\n\ts_mov_b32 m0, %2\n\ts_nop 0\n\tglobal_load_lds_dwordx4 %1, off\n\ts_mov_b32 m0, %0":"=&s"(keep):"v"(gsrc),"s"(lds_dst):"memory");}
__device__ __forceinline__ float max3f(float a,float b,float c){float r;asm("v_max3_f32 %0, %1, %2, %3":"=v"(r):"v"(a),"v"(b),"v"(c));return r;}
__device__ __forceinline__ float max2f(float a,float b){float r;asm("v_max_f32_e32 %0, %1, %2":"=v"(r):"v"(a),"v"(b));return r;}
__device__ __forceinline__ float fadd_s(float a,float b){float r;asm("v_add_f32_e32 %0, %1, %2":"=v"(r):"v"(a),"v"(b));return r;}
__device__ __forceinline__ float fsub_s(float a,float b){float r;asm("v_sub_f32_e32 %0, %1, %2":"=v"(r):"v"(a),"v"(b));return r;}
typedef float f32x2_t __attribute__((ext_vector_type(2))); typedef __bf16 bf16x2_t __attribute__((ext_vector_type(2)));
__device__ __forceinline__ unsigned cvtpk_s(float lo,float hi){f32x2_t v={lo,hi};bf16x2_t b=__builtin_convertvector(v,bf16x2_t);return __builtin_bit_cast(unsigned,b);}
#define WAIT_BAR(N) asm volatile("s_waitcnt vmcnt(" #N ") lgkmcnt(0)\n\ts_barrier":::"memory")

__device__ __forceinline__ void qkt(f32x16&p0,f32x16&p1,const char*Kslot,const bf16x8*qr,const f32x16&negm,int r32,int hi){
  const char*kb=Kslot+hi*1024+r32*16;
  #pragma unroll
  for(int d0=0;d0<4;++d0){
    const bf16x8 b0=*reinterpret_cast<const bf16x8*>(kb+d0*2048);
    const bf16x8 b1=*reinterpret_cast<const bf16x8*>(kb+d0*2048+512);
    if(d0==0){p0=__builtin_amdgcn_mfma_f32_32x32x16_bf16(b0,qr[0],negm,0,0,0);p1=__builtin_amdgcn_mfma_f32_32x32x16_bf16(b1,qr[0],negm,0,0,0);}
    else{p0=__builtin_amdgcn_mfma_f32_32x32x16_bf16(b0,qr[d0],p0,0,0,0);p1=__builtin_amdgcn_mfma_f32_32x32x16_bf16(b1,qr[d0],p1,0,0,0);}}
}
typedef __attribute__((address_space(3))) const char* lds_cptr;
typedef short v4i16_t __attribute__((ext_vector_type(4)));
__device__ __forceinline__ void kload8(bf16x8*kf,lds_cptr kp){
  kf[0]=*(const __attribute__((address_space(3))) bf16x8*)(kp);      kf[1]=*(const __attribute__((address_space(3))) bf16x8*)(kp+512);
  kf[2]=*(const __attribute__((address_space(3))) bf16x8*)(kp+2048); kf[3]=*(const __attribute__((address_space(3))) bf16x8*)(kp+2560);
  kf[4]=*(const __attribute__((address_space(3))) bf16x8*)(kp+4096); kf[5]=*(const __attribute__((address_space(3))) bf16x8*)(kp+4608);
  kf[6]=*(const __attribute__((address_space(3))) bf16x8*)(kp+6144); kf[7]=*(const __attribute__((address_space(3))) bf16x8*)(kp+6656);
}
__device__ __forceinline__ void kload2(bf16x8*kf,lds_cptr kp,int j){ kf[2*j]=*(const __attribute__((address_space(3))) bf16x8*)(kp+j*2048); kf[2*j+1]=*(const __attribute__((address_space(3))) bf16x8*)(kp+j*2048+512); }
__device__ __forceinline__ s16x4 vtr(lds_cptr p){ return __builtin_bit_cast(s16x4,__builtin_amdgcn_ds_read_tr16_b64_v4i16((__attribute__((address_space(3))) v4i16_t*)p)); }
__device__ __forceinline__ float rowmax(const f32x16&p0,const f32x16&p1){
  float a=max3f(p0[0],p0[1],p1[0]),b=max3f(p0[2],p0[3],p1[1]);a=max3f(a,p1[2],p1[3]);
  #pragma unroll
  for(int r=4;r<16;r+=4){a=max3f(a,p0[r],p0[r+1]);b=max3f(b,p0[r+2],p0[r+3]);a=max3f(a,p1[r],p1[r+1]);b=max3f(b,p1[r+2],p1[r+3]);}
  const float m=max2f(a,b);
  auto rr=__builtin_amdgcn_permlane32_swap(__float_as_uint(m),__float_as_uint(m),false,false);
  return max2f(__uint_as_float(rr[0]),__uint_as_float(rr[1]));
}
__device__ __forceinline__ void pv(f32x16*o,int vb,bf16x8 pa0,bf16x8 pa1,bf16x8 pa2,bf16x8 pa3){
  #pragma unroll
  for(int d0=0;d0<2;++d0){s16x4 lo[4],hi[4];
    #pragma unroll
    for(int ks=0;ks<4;++ks){
      asm volatile("ds_read_b64_tr_b16 %0,%1 offset:%c2":"=&v"(lo[ks]):"v"(vb),"i"(d0*4096+ks*1024):"memory");
      asm volatile("ds_read_b64_tr_b16 %0,%1 offset:%c2":"=&v"(hi[ks]):"v"(vb),"i"(d0*4096+ks*1024+512):"memory");}
    asm volatile("s_waitcnt lgkmcnt(0)":::"memory");SBAR();
    #define PK(k) (bf16x8){lo[k][0],lo[k][1],lo[k][2],lo[k][3],hi[k][0],hi[k][1],hi[k][2],hi[k][3]}
    o[d0]=__builtin_amdgcn_mfma_f32_32x32x16_bf16(pa0,PK(0),o[d0],0,0,0);
    o[d0]=__builtin_amdgcn_mfma_f32_32x32x16_bf16(pa1,PK(1),o[d0],0,0,0);
    o[d0]=__builtin_amdgcn_mfma_f32_32x32x16_bf16(pa2,PK(2),o[d0],0,0,0);
    o[d0]=__builtin_amdgcn_mfma_f32_32x32x16_bf16(pa3,PK(3),o[d0],0,0,0);
    #undef PK
  }
}

#ifndef ATTN_STORE16
#define ATTN_STORE16(p,v) (*(u32x4*)(p)=(v))
#endif
template<int THRL> __device__ __forceinline__ void attn_unit(int b,int h,int qb,const bf16*Q,const bf16*__restrict__ K,const bf16*__restrict__ V,bf16*O,const float*ksum,char*shm,const int tid){
  const int lane=tid&63,r32=lane&31,hi=lane>>5; const int wid=__builtin_amdgcn_readfirstlane(tid>>6);
  const long rowbase=(long)b*SEQ; const int q0=qb*QB;
  const bf16*Qw=Q+(rowbase+q0+wid*QBLK)*DM+h*D;
  const bf16*Kh=K+rowbase*DM+h*D,*Vh=V+rowbase*DM+h*D;
  const unsigned lds0=(unsigned)(uintptr_t)shm;
  float*wsf=(float*)(shm+LDS_WS)+wid*64;
  const bf16*ksrc=Kh+(long)lane*DM+wid*8;
  const bf16*vsrc=Vh+(long)(16*(wid&3)+(lane>>2))*DM+(wid>>2)*32+(lane&3)*8;
  const unsigned kdst=lds0+LDS_K+wid*1024, vdst=lds0+LDS_V+wid*1024;
  #define KT(t) (((t)<4)?(4*qb+(t)):((t)-4))
  #define DMA_K(t,slot) glds16(ksrc+(long)KT(t)*KVBLK*DM,(unsigned)__builtin_amdgcn_readfirstlane(kdst+(slot)))
  #define DMA_V(t,slot) glds16(vsrc+(long)KT(t)*KVBLK*DM,(unsigned)__builtin_amdgcn_readfirstlane(vdst+(slot)))
  const int vb0=(int)(lds0+LDS_V)+((lane>>4)&1)*32+(lane&3)*8+(4*hi+((lane&15)>>2))*64;
  const char*Kbase=shm+LDS_K; bf16x8 kf[8];
  const lds_cptr shm3=(lds_cptr)shm; const lds_cptr kp0=shm3+LDS_K+hi*1024+r32*16; const lds_cptr vp0=shm3+LDS_V+((lane>>4)&1)*32+(lane&3)*8+(4*hi+((lane&15)>>2))*64;
  const int NT=(q0+QB)/KVBLK;
  if(qb>3&&tid<448){const int j_=tid>>6,d_=tid&63; if(j_<qb){const float*kp_=ksum+((long)(b*8+j_))*1024+h*D+d_; float a_=kp_[0]+kp_[(long)64*1024]; ((float*)(shm+LDS_KM))[tid]=a_;}}
  asm volatile("s_waitcnt vmcnt(0)":::"memory");
  DMA_K(0,0);DMA_V(0,0);DMA_K(1,SLOTB);
  bf16x8 qr[4];
  #pragma unroll
  for(int d0=0;d0<4;++d0)qr[d0]=*reinterpret_cast<const bf16x8*>(&Qw[(long)r32*DM+d0*16+hi*8]);
  float mhat=0.f,l_reg=0.f;f32x16 o[2];o[0]=f32x16{};o[1]=f32x16{};f32x16 negm=f32x16{};asm volatile("":"+v"(negm));
  const int qrel=wid*QBLK+r32;
  #define CMASK(P0,P1,t) do{ if((t)<4)cmask(P0,P1,(t),qrel,hi);}while(0)
  bool resc=false;
  #define START(P0,P1) do{ const float rm=rowmax(P0,P1); resc=false; \
    { const float dl=rm; mhat=fadd_s(mhat,dl); \
      _Pragma("unroll") for(int r=0;r<16;++r){P0[r]=fsub_s(P0[r],dl);P1[r]=fsub_s(P1[r],dl);} \
      _Pragma("unroll") for(int r=0;r<16;++r)negm[r]=-mhat; asm volatile("":"+v"(negm)); } \
    _Pragma("unroll") for(int r=0;r<16;++r)P0[r]=__builtin_amdgcn_exp2f(P0[r]); }while(0)
  #define RESC() do{ if(resc){ asm volatile("s_waitcnt lgkmcnt(0)":::"memory"); \
      _Pragma("unroll") for(int d_=0;d_<2;++d_) _Pragma("unroll") for(int r=0;r<16;++r)o[d_][r]*=wsf[crow(r,hi)]; } }while(0)
  f32x16 pA0,pA1,pB0,pB1;
  int sl_prev=0,sl_cur=0,sl_next=SLOTB;
  #define ROT() do{sl_prev=sl_cur;sl_cur=sl_next;sl_next=(sl_next==(NSLOT-1)*SLOTB)?0:sl_next+SLOTB;}while(0)
  DMA_K(2,2*SLOTB);
  WAIT_BAR(3);
  unsigned selbits=0xffu;
  if(qb>3){ float t0_=-INFINITY,t1_=-INFINITY,t2_=-INFINITY; int i0_=0,i1_=0,i2_=0; const float*kmf=(const float*)(shm+LDS_KM)+8*hi;
    _Pragma("unroll 1") for(int j_=0;j_<qb;++j_){ float s_=0.f;
      _Pragma("unroll") for(int d0=0;d0<4;++d0){ const f32x4_t ka=*(const f32x4_t*)(kmf+j_*64+d0*16), kb=*(const f32x4_t*)(kmf+j_*64+d0*16+4);
        s_+=bf2f_(qr[d0][0])*ka[0]+bf2f_(qr[d0][1])*ka[1]+bf2f_(qr[d0][2])*ka[2]+bf2f_(qr[d0][3])*ka[3]+bf2f_(qr[d0][4])*kb[0]+bf2f_(qr[d0][5])*kb[1]+bf2f_(qr[d0][6])*kb[2]+bf2f_(qr[d0][7])*kb[3]; }
      s_+=__shfl_xor(s_,32);
      if(s_>t0_){t2_=t1_;i2_=i1_;t1_=t0_;i1_=i0_;t0_=s_;i0_=j_;} else if(s_>t1_){t2_=t1_;i2_=i1_;t1_=s_;i1_=j_;} else if(s_>t2_){t2_=s_;i2_=j_;} }
    selbits=(1u<<i0_)|(1u<<i1_)|(1u<<i2_); }
  #define BSEL(t) (((t)<4)||((selbits>>(((t)-4)>>2))&1u))
  qkt(pA0,pA1,Kbase,qr,negm,r32,hi);asm volatile("s_nop 15\n\ts_nop 7":"+v"(pA0),"+v"(pA1));CMASK(pA0,pA1,0);
  START(pA0,pA1);
  _Pragma("unroll") for(int r=0;r<16;++r)pA1[r]=__builtin_amdgcn_exp2f(pA1[r]);
  WAIT_BAR(0);
  DMA_K(3,0);DMA_V(1,SLOTB);
  ROT();
  kload8(kf,kp0+sl_cur);
  WAIT_BAR(2);
  s16x4 vlo[8],vhi[8]; u32x4 pw0,pw1,pw2,pw3;
  #define PKW(P,B) cvtpk_s(P[B],P[B+1])
  #define PAF(k) __builtin_bit_cast(bf16x8,pw##k)
  #define VFR(i) (bf16x8){vlo[i][0],vlo[i][1],vlo[i][2],vlo[i][3],vhi[i][0],vhi[i][1],vhi[i][2],vhi[i][3]}
  #define PIN(x) asm volatile("":"+v"(x))
  #define MX3(a,b,c) __builtin_fmaxf(__builtin_fmaxf((a),(b)),(c))
  #define GAPA(MF,A0,A1,A2,A3,W0,W1,PW) do{ MF; sacc+=A0; sacc+=A1; sacc+=A2; sacc+=A3; PIN(sacc); W0; W1; PIN(PW); SBAR(); }while(0)
  #define EX(v) __builtin_amdgcn_exp2f(v)
  #define GAPB(MF,X,B) do{ MF; X[B]=EX(X[B]); X[B+1]=EX(X[B+1]); X[B+2]=EX(X[B+2]); X[B+3]=EX(X[B+3]); PIN(X); SBAR(); }while(0)
  #define VRD(i) do{ vlo[i]=vtr(vp_+(((i)>>2)*4096+((i)&3)*1024)); vhi[i]=vtr(vp_+(((i)>>2)*4096+((i)&3)*1024+512)); }while(0)
  #define KRD(G,j) do{ if(G){ kload2(kf,kp0+sl_next,j); SBAR(); } }while(0)
  #define STEP(C0,C1,P0,P1,t,GK,GV,GL) do{ if((((t)&3)==0)&&((t)>=4)){ const float nm_=BSEL(t)?-mhat:NEGBIG; _Pragma("unroll") for(int r=0;r<16;++r)negm[r]=nm_; asm volatile("":"+v"(negm)); } SBAR(); \
    const lds_cptr vp_=vp0+sl_prev; \
    VRD(0); SBAR(); float sacc=(P0[0]+P0[1]); \
    GAPA(C0=__builtin_amdgcn_mfma_f32_32x32x16_bf16(kf[0],qr[0],negm,0,0,0), P0[2],P0[3],P0[4],P0[5],     pw0[0]=PKW(P0,0), pw0[1]=PKW(P0,2), pw0); \
    VRD(4); SBAR(); GAPA(C1=__builtin_amdgcn_mfma_f32_32x32x16_bf16(kf[1],qr[0],negm,0,0,0), P0[6],P0[7],P0[8],P0[9],     pw0[2]=PKW(P0,4), pw0[3]=PKW(P0,6), pw0); \
    VRD(1); SBAR(); GAPA(C0=__builtin_amdgcn_mfma_f32_32x32x16_bf16(kf[2],qr[1],C0,0,0,0),   P0[10],P0[11],P0[12],P0[13], pw1[0]=PKW(P0,8), pw1[1]=PKW(P0,10), pw1); \
    VRD(5); SBAR(); GAPA(C1=__builtin_amdgcn_mfma_f32_32x32x16_bf16(kf[3],qr[1],C1,0,0,0),   P0[14],P0[15],P1[0],P1[1],   pw1[2]=PKW(P0,12),pw1[3]=PKW(P0,14), pw1); \
    VRD(2); SBAR(); GAPA(C0=__builtin_amdgcn_mfma_f32_32x32x16_bf16(kf[4],qr[2],C0,0,0,0),   P1[2],P1[3],P1[4],P1[5],     pw2[0]=PKW(P1,0), pw2[1]=PKW(P1,2), pw2); \
    VRD(6); SBAR(); GAPA(C1=__builtin_amdgcn_mfma_f32_32x32x16_bf16(kf[5],qr[2],C1,0,0,0),   P1[6],P1[7],P1[8],P1[9],     pw2[2]=PKW(P1,4), pw2[3]=PKW(P1,6), pw2); \
    VRD(3); SBAR(); GAPA(C0=__builtin_amdgcn_mfma_f32_32x32x16_bf16(kf[6],qr[3],C0,0,0,0),   P1[10],P1[11],P1[12],P1[13], pw3[0]=PKW(P1,8), pw3[1]=PKW(P1,10), pw3); \
    VRD(7); SBAR(); GAPA(C1=__builtin_amdgcn_mfma_f32_32x32x16_bf16(kf[7],qr[3],C1,0,0,0),   P1[14],P1[15],0.f,0.f,       pw3[2]=PKW(P1,12),pw3[3]=PKW(P1,14), pw3); \
    l_reg+=sacc; \
    if(GK){DMA_K((t)+3,sl_cur);} if(GV){DMA_V((t)+1,sl_next);} \
    CMASK(C0,C1,t); \
    { float a=MX3(C0[0],C0[1],C1[0]),b=MX3(C0[2],C0[3],C1[1]); a=MX3(a,C1[2],C1[3]); \
      _Pragma("unroll") for(int r=4;r<16;r+=4){a=MX3(a,C0[r],C0[r+1]);b=MX3(b,C0[r+2],C0[r+3]);a=MX3(a,C1[r],C1[r+1]);b=MX3(b,C1[r+2],C1[r+3]);} \
      float rm=__builtin_fmaxf(a,b); { auto rr=__builtin_amdgcn_permlane32_swap(__float_as_uint(rm),__float_as_uint(rm),false,false); rm=__builtin_fmaxf(__uint_as_float(rr[0]),__uint_as_float(rr[1])); } \
      resc=false; \
      if(__builtin_expect(__any(rm>(float)THRL),0)){ const float dl=__builtin_fmaxf(rm,0.f); mhat+=dl; \
        _Pragma("unroll") for(int r=0;r<16;++r){C0[r]-=dl;C1[r]-=dl;} \
        { const float nm_=BSEL((t)+1)?-mhat:NEGBIG; _Pragma("unroll") for(int r=0;r<16;++r)negm[r]=nm_; } asm volatile("":"+v"(negm)); \
        const float f=__builtin_amdgcn_exp2f(-dl); l_reg*=f; if(hi==0)wsf[r32]=f; resc=true; } } \
    SBAR(); \
    GAPB(o[0]=__builtin_amdgcn_mfma_f32_32x32x16_bf16(PAF(0),VFR(0),o[0],0,0,0), C0,0); \
    GAPB(o[1]=__builtin_amdgcn_mfma_f32_32x32x16_bf16(PAF(0),VFR(4),o[1],0,0,0), C0,4); \
    KRD(GL,0); GAPB(o[0]=__builtin_amdgcn_mfma_f32_32x32x16_bf16(PAF(1),VFR(1),o[0],0,0,0), C0,8); \
    KRD(GL,1); GAPB(o[1]=__builtin_amdgcn_mfma_f32_32x32x16_bf16(PAF(1),VFR(5),o[1],0,0,0), C0,12); \
    KRD(GL,2); GAPB(o[0]=__builtin_amdgcn_mfma_f32_32x32x16_bf16(PAF(2),VFR(2),o[0],0,0,0), C1,0); \
    KRD(GL,3); GAPB(o[1]=__builtin_amdgcn_mfma_f32_32x32x16_bf16(PAF(2),VFR(6),o[1],0,0,0), C1,4); \
    GAPB(o[0]=__builtin_amdgcn_mfma_f32_32x32x16_bf16(PAF(3),VFR(3),o[0],0,0,0), C1,8); \
    GAPB(o[1]=__builtin_amdgcn_mfma_f32_32x32x16_bf16(PAF(3),VFR(7),o[1],0,0,0), C1,12); \
    }while(0)
  int t=1;
  #define ENDW(tt) do{ if((tt)+3<NT){WAIT_BAR(2);} else if((tt)+2<NT){WAIT_BAR(1);} else {WAIT_BAR(0);} }while(0)
  #define GPAIR() do{ STEP(pB0,pB1,pA0,pA1,t,(t+3<NT),(t+1<NT),(t+1<NT));       ENDW(t);   RESC(); ROT(); \
                      STEP(pA0,pA1,pB0,pB1,t+1,(t+4<NT),(t+2<NT),(t+2<NT));     ENDW(t+1); RESC(); ROT(); }while(0)
  for(;t<5&&t+1<NT;t+=2){ GPAIR(); }
  #undef CMASK
  #define CMASK(P0,P1,t) do{}while(0)
  for(;t+5<NT;t+=2){
    STEP(pB0,pB1,pA0,pA1,t,true,true,true);     WAIT_BAR(2); RESC(); ROT();
    STEP(pA0,pA1,pB0,pB1,t+1,true,true,true);   WAIT_BAR(2); RESC(); ROT();
  }
  #undef CMASK
  #define CMASK(P0,P1,t) do{ if((t)<4)cmask(P0,P1,(t),qrel,hi);}while(0)
  for(;t+1<NT;t+=2){ GPAIR(); }
  STEP(pB0,pB1,pA0,pA1,NT-1,false,false,false); RESC();
  { float sacc=pB0[0]+pB0[1]; _Pragma("unroll") for(int r=2;r<16;++r)sacc+=pB0[r]; _Pragma("unroll") for(int r=0;r<16;++r)sacc+=pB1[r]; l_reg+=sacc;
    pw0=(u32x4){PKW(pB0,0),PKW(pB0,2),PKW(pB0,4),PKW(pB0,6)};pw1=(u32x4){PKW(pB0,8),PKW(pB0,10),PKW(pB0,12),PKW(pB0,14)};pw2=(u32x4){PKW(pB1,0),PKW(pB1,2),PKW(pB1,4),PKW(pB1,6)};pw3=(u32x4){PKW(pB1,8),PKW(pB1,10),PKW(pB1,12),PKW(pB1,14)};
    SBAR(); pv(o,vb0+sl_cur,PAF(0),PAF(1),PAF(2),PAF(3)); }
  #undef PKW
  #undef PAF
  #undef VFR
  #undef PIN
  #undef MX3
  #undef GAPA
  #undef GAPB
  #undef EX
  #undef VRD
  #undef KRD
  #undef STEP
  #undef ENDW
  #undef GPAIR
  #undef BSEL
  int hi2=hi,r32b=r32; asm volatile("":"+v"(hi2),"+v"(r32b));
  {auto rr=__builtin_amdgcn_permlane32_swap(__float_as_uint(l_reg),__float_as_uint(l_reg),false,false);l_reg=__uint_as_float(rr[0])+__uint_as_float(rr[1]);}
  if(hi2==0)wsf[32+r32b]=l_reg;asm volatile("s_waitcnt lgkmcnt(0)":::"memory");
  float rli[16];
  #pragma unroll
  for(int r=0;r<16;++r)rli[r]=__builtin_amdgcn_rcpf(wsf[32+crow(r,hi2)]);
  bf16*Ow=O+(rowbase+q0+wid*QBLK)*DM+h*D;
  { bf16*stg=(bf16*)(shm+LDS_OST)+wid*2048;
    #pragma unroll
    for(int r=0;r<16;++r){const int orow=crow(r,hi2);
      #pragma unroll
      for(int d0=0;d0<2;++d0)stg[orow*64+d0*32+r32b]=__float2bfloat16(o[d0][r]*rli[r]);}
    asm volatile("s_waitcnt lgkmcnt(0)":::"memory");
    #pragma unroll
    for(int i=0;i<4;++i){const int row=i*8+(lane>>3),ch=lane&7; const u32x4 v=*(const u32x4*)(stg+row*64+ch*8); ATTN_STORE16(Ow+(long)row*DM+ch*8,v);} }
  asm volatile("s_waitcnt lgkmcnt(0)\n\ts_barrier":::"memory");
  #undef KT
  #undef DMA_K
  #undef DMA_V
  #undef CMASK
  #undef START
  #undef RESC
  #undef ROT
}
constexpr int ATTN_LDS_BYTES=LDS_BYTES;
struct AttnTensors { const bf16* Q; const bf16* K; const bf16* V; bf16* O; const float* ksum; };
struct AttnUnit { int bh; int qb; };
struct MobaOrder {
  int vcu;
  __device__ __forceinline__ bool next(int i,AttnUnit&u)const{ if(i>=4)return false; const int s=vcu&1; u.bh=vcu>>1;
    u.qb=(s==0)?((i==0)?7:(i==1)?0:(i==2)?5:2):((i==0)?6:(i==1)?1:(i==2)?4:3); return true; }
};
template<class Sched,int THRL=8> __device__ __forceinline__ void attn_phase(char*lds,const AttnTensors&T,const Sched&S,const int tid){
  AttnUnit u;
  for(int i=0;S.next(i,u);++i){ attn_unit<THRL>(u.bh/NHEAD,u.bh%NHEAD,u.qb,T.Q,T.K,T.V,T.O,T.ksum,lds,tid); }
}
#undef SBAR
#undef WAIT_BAR
}
#define GAS __attribute__((address_space(1)))
#define LAS __attribute__((address_space(3)))
typedef unsigned short bf16;
typedef unsigned v4u __attribute__((ext_vector_type(4)));
typedef float f32x4 __attribute__((ext_vector_type(4)));
typedef short bf16x8 __attribute__((ext_vector_type(8)));
typedef GAS unsigned gu32;
typedef GAS unsigned long long gu64;
#define RLX_AGENT __ATOMIC_RELAXED, __HIP_MEMORY_SCOPE_AGENT
#define LDS_WAIT() asm volatile("s_waitcnt lgkmcnt(0)" ::: "memory")
#define VM_WAIT() asm volatile("s_waitcnt vmcnt(0)" ::: "memory")
__device__ __forceinline__ unsigned long long rt() { return __builtin_amdgcn_s_memrealtime(); }
__device__ __forceinline__ unsigned f2bf(float f) { unsigned u = __builtin_bit_cast(unsigned, f); return (u + 0x7fffu + ((u >> 16) & 1u)) >> 16; }
__device__ __forceinline__ unsigned pk2(float lo, float hi) { return f2bf(lo) | (f2bf(hi) << 16); }

#define XB_TMO      128
#define XB_XCNT(j)  (256  + 64 * (j))
#define XB_XSUB(j)  (1280 + 64 * (j))
#define XB_XGEN(j)  (2304 + 64 * (j))
#define XB_TOP      3328
#define XB_TOPGEN   3392
#define XCD_BAR_WORDS 3456
#define XB_SPIN_CAP (1u << 18)

__device__ __forceinline__ unsigned xb_ld(unsigned* p)              { return __hip_atomic_load(p, __ATOMIC_RELAXED, __HIP_MEMORY_SCOPE_AGENT); }
__device__ __forceinline__ unsigned xb_add(unsigned* p, unsigned v) { return __hip_atomic_fetch_add(p, v, __ATOMIC_RELAXED, __HIP_MEMORY_SCOPE_AGENT); }
__device__ __forceinline__ unsigned xb_xcc_id() { return (unsigned)__builtin_amdgcn_s_getreg((3 << 11) | 20) & 0xFu; }
#define XB_SPIN(cond, bar) do { unsigned _sp = 0; while (cond) { __builtin_amdgcn_s_sleep(1); \
    if ((++_sp & 255u) == 0u) { if (xb_ld(&(bar)[XB_TMO])) break; if (_sp > XB_SPIN_CAP) { atomicAdd(&(bar)[XB_TMO], 1u); break; } } } } while (0)

struct XcdBarrier {
    unsigned* bar; unsigned x;
    volatile LAS unsigned* st;
};

__device__ __forceinline__ XcdBarrier xcd_barrier_post(unsigned* bar, volatile LAS unsigned* st) {
    XcdBarrier b; b.bar = bar; b.x = xb_xcc_id(); b.st = st;
    if (threadIdx.x == 0) (void)xb_add(&bar[XB_XCNT(b.x)], 1u);
    return b;
}
__device__ __forceinline__ void xcd_barrier_complete(unsigned* bar, unsigned x, unsigned& nloc, unsigned& nx) {
    const unsigned G = gridDim.x * gridDim.y * gridDim.z;
    unsigned sum, cnt, mine, sp = 0u;
    for (;;) {
        sum = 0u; cnt = 0u; mine = 0u;
#pragma unroll
        for (unsigned j = 0; j < 16; ++j) { const unsigned c = xb_ld(&bar[XB_XCNT(j)]); sum += c; cnt += (c > 0u) ? 1u : 0u; mine = (j == x) ? c : mine; }
        if (sum == G) break;
        __builtin_amdgcn_s_sleep(1);
        if ((++sp & 255u) == 0u) { if (xb_ld(&bar[XB_TMO])) break; if (sp > XB_SPIN_CAP) { atomicAdd(&bar[XB_TMO], 1u); break; } }
    }
    nloc = mine > 0u ? mine : 1u; nx = cnt > 0u ? cnt : 1u;
}

__device__ __forceinline__ void xcd_barrier(const XcdBarrier& b) {
    asm volatile("s_waitcnt vmcnt(0)" ::: "memory");
    __syncthreads();
    if (threadIdx.x == 0) {
        unsigned* bar = b.bar;
        __builtin_amdgcn_s_waitcnt(0);
        unsigned nloc = b.st[0], nx = b.st[1];
        if (nloc == 0u) { xcd_barrier_complete(bar, b.x, nloc, nx); b.st[0] = nloc; b.st[1] = nx; }
        const unsigned old = xb_add(&bar[XB_XSUB(b.x)], 1u);
        const unsigned gen = old / nloc;
        if (old + 1u == (gen + 1u) * nloc) {
            __builtin_amdgcn_fence(__ATOMIC_RELEASE, "agent");
            asm volatile("s_waitcnt vmcnt(0)" ::: "memory");
            const unsigned og = xb_add(&bar[XB_TOP], 1u);
            const unsigned tg = og / nx;
            if (og + 1u == (tg + 1u) * nx) xb_add(&bar[XB_TOPGEN], 1u);
            else XB_SPIN(xb_ld(&bar[XB_TOPGEN]) == tg, bar);
            __builtin_amdgcn_fence(__ATOMIC_ACQUIRE, "agent");
            xb_add(&bar[XB_XGEN(b.x)], 1u);
            asm volatile("s_waitcnt vmcnt(0)" ::: "memory");
        } else {
            XB_SPIN(xb_ld(&bar[XB_XGEN(b.x)]) == gen, bar);
            __builtin_amdgcn_fence(__ATOMIC_ACQUIRE, "agent");
            asm volatile("s_waitcnt vmcnt(0)" ::: "memory");
        }
    }
    __syncthreads();
}
constexpr int NWAVES = 8;
constexpr int BATCH = 8, SEQ = 2048, D = 1024, NH = 16, HD = 64, DEPTH = 4;
constexpr int M = BATCH * SEQ;
constexpr int NQKV = 3 * D, DV = 3072, NZ = 2 * DV, GG = 8, GD = 384, CHK = 128;
constexpr int NE = 64, EPG = 8, FE = 256, NRT = 80;
constexpr float LN_EPS = 1e-5f, ALPHA = 1.681792830507429f;
constexpr float QSCALE = 0.125f * 1.4426950408889634f;
constexpr int TOKCAP = 16384;
constexpr int MAXTILES = 192;

constexpr size_t MiB = 1u << 20;
constexpr size_t WS_CTL = 0, CTL_ZERO_BYTES = 1 * MiB;
constexpr size_t WS_WQKV = 2 * MiB;
constexpr size_t WS_WO = 14 * MiB;
constexpr size_t WS_WIN = 18 * MiB;
constexpr size_t WS_WOUT = 42 * MiB;
constexpr size_t WS_WR = 54 * MiB;
constexpr size_t WS_XB = 56 * MiB;
constexpr size_t WS_KSUM = 57 * MiB;
constexpr size_t WS_VPART = 58 * MiB;
constexpr size_t WS_TOK = 64 * MiB;
constexpr size_t WS_ASG = 68 * MiB;
constexpr size_t WS_XN = 72 * MiB;
constexpr size_t WS_QO = 104 * MiB, WS_K = 136 * MiB, WS_V = 168 * MiB;
constexpr size_t WS_U = 104 * MiB, WS_VV = 200 * MiB;
constexpr size_t WS_HB = 296 * MiB;
constexpr size_t WS_YB = 320 * MiB;
constexpr size_t WS_W13 = 416 * MiB;
constexpr size_t WS_W2 = 672 * MiB;
constexpr size_t WS_END = 800 * MiB;
constexpr int CW_TMO = 0, CW_CODE = 1;
constexpr int CW_BAR = 4096;
constexpr int CW_SEAM = 16384;
constexpr int CW_CNT = 32768;
constexpr int RING_OFF = 0, RING_BYTES = 131072;
constexpr int LDSCTL_OFF = RING_BYTES, MISC_OFF = LDSCTL_OFF + 320;
constexpr int TAB_OFF = LDSCTL_OFF + 1024;
constexpr int LDS_BYTES = 147456;

struct Args { const float* in[21]; float* out; unsigned char* ws; int ph_lo, ph_hi; };
struct Frame {
    LAS unsigned char* lds;
    volatile LAS unsigned* MISC;
    gu32* ctl;
    int tid, lane, wave;
    int vcu, G;
    float* out; unsigned char* ws;
    bf16 *XN, *QO, *KB, *VB, *UB, *VVB, *HB, *YB;
};
__device__ __forceinline__ float wave_sum(float v) {
#pragma unroll
    for (int o = 1; o < 64; o <<= 1) v += __shfl_xor(v, o);
    return v;
}
__device__ __forceinline__ float bflo(unsigned w) { return __uint_as_float(w << 16); }
__device__ __forceinline__ float bfhi(unsigned w) { return __uint_as_float(w & 0xffff0000u); }
template <class T> __device__ __forceinline__ T* opaque(T* p) { asm volatile("" : "+v"(p)); return p; }

__device__ __forceinline__ void p0_transpose_tile(const float* W, int N, int k0, int n0, bf16* WTrow, int ldt, LAS float* scr, int lane) {
#pragma unroll 4
    for (int i = 0; i < 32; ++i) { const int kk = 2 * i + (lane >> 5); scr[kk * 33 + (lane & 31)] = W[(size_t)(k0 + kk) * N + n0 + (lane & 31)]; }
    LDS_WAIT(); asm volatile("" ::: "memory");
    const int c = lane & 7;
#pragma unroll
    for (int j = 0; j < 4; ++j) { const int n = (lane >> 3) + 8 * j; const LAS float* s = scr + (8 * c) * 33 + n;
        v4u o; o.x = pk2(s[0 * 33], s[1 * 33]); o.y = pk2(s[2 * 33], s[3 * 33]); o.z = pk2(s[4 * 33], s[5 * 33]); o.w = pk2(s[6 * 33], s[7 * 33]);
        *(GAS v4u*)(WTrow + (size_t)n * ldt + k0 + 8 * c) = o; }
    LDS_WAIT(); asm volatile("" ::: "memory");
}
__device__ __forceinline__ void p0_prologue(Frame& F, const Args& A) {
    LAS float* scr = (LAS float*)(F.lds + RING_OFF + F.wave * 16384);
    const int gw = F.vcu * NWAVES + F.wave, NGW = F.G * NWAVES;
    unsigned char* ws = F.ws;
    constexpr int I_QKV = 16 * 96, I_WO = 16 * 32, I_WIN = 16 * 192, I_WOUT = 48 * 32, I_DENSE = 2 * (I_QKV + I_WO + I_WIN + I_WOUT);
    constexpr int I_E = 128, I_MOE = DEPTH * NE * 3 * I_E;
    for (int it = gw; it < I_DENSE + I_MOE; it += NGW) {
        int r = it;
        if (r < I_DENSE) {
            if (r < 2 * I_QKV) { const int j = r / I_QKV; r %= I_QKV; const int kb = r / 96, nb = r % 96;
                p0_transpose_tile(A.in[1] + (size_t)j * D * NQKV, NQKV, kb * 64, nb * 32, (bf16*)(ws + WS_WQKV) + (size_t)j * NQKV * D + (size_t)(nb * 32) * D, D, scr, F.lane); continue; } r -= 2 * I_QKV;
            if (r < 2 * I_WO) { const int j = r / I_WO; r %= I_WO; const int kb = r / 32, nb = r % 32;
                p0_transpose_tile(A.in[2] + (size_t)j * D * D, D, kb * 64, nb * 32, (bf16*)(ws + WS_WO) + (size_t)j * D * D + (size_t)(nb * 32) * D, D, scr, F.lane); continue; } r -= 2 * I_WO;
            if (r < 2 * I_WIN) { const int j = r / I_WIN; r %= I_WIN; const int kb = r / 192, nb = r % 192;
                p0_transpose_tile(A.in[3] + (size_t)j * D * NZ, NZ, kb * 64, nb * 32, (bf16*)(ws + WS_WIN) + (size_t)j * NZ * D + (size_t)(nb * 32) * D, D, scr, F.lane); continue; } r -= 2 * I_WIN;
            { const int j = r / I_WOUT; r %= I_WOUT; const int kb = r / 32, nb = r % 32;
                p0_transpose_tile(A.in[9] + (size_t)j * DV * D, D, kb * 64, nb * 32, (bf16*)(ws + WS_WOUT) + (size_t)j * D * DV + (size_t)(nb * 32) * DV, DV, scr, F.lane); continue; }
        }
        r -= I_DENSE;
        const int le = r / (3 * I_E); r %= 3 * I_E; const int which = r / I_E; r %= I_E;
        if (which < 2) {
            const int kb = r / 8, nb = r % 8, n0 = nb * 32;
            p0_transpose_tile(A.in[18 + which] + (size_t)le * D * FE, FE, kb * 64, n0, (bf16*)(ws + WS_W13) + (size_t)le * 512 * D + (size_t)((n0 >> 7) * 256 + which * 128 + (n0 & 127)) * D, D, scr, F.lane);
        } else {
            const int kb = r / 32, nb = r % 32;
            p0_transpose_tile(A.in[20] + (size_t)le * FE * D, D, kb * 64, nb * 32, (bf16*)(ws + WS_W2) + (size_t)le * D * FE + (size_t)(nb * 32) * FE, FE, scr, F.lane);
        }
    }
    const int gt = F.vcu * (NWAVES * 64) + F.tid, NGT = F.G * NWAVES * 64;
    for (int idx = gt; idx < DEPTH * NRT * D; idx += NGT) {
        const int l = idx / (NRT * D), n = (idx / D) % NRT, k = idx % D;
        float w = 0.f; if (n < 8) w = A.in[14][((size_t)l * D + k) * 8 + n]; else if (n < 72) w = A.in[16][((size_t)l * D + k) * NE + (n - 8)];
        const unsigned hi = f2bf(w); const float lo = w - __uint_as_float(hi << 16);
        bf16* wr = (bf16*)(ws + WS_WR) + (size_t)l * 2 * NRT * D + (size_t)n * D + k;
        wr[0] = (bf16)hi; wr[(size_t)NRT * D] = (bf16)f2bf(lo);
    }
    for (int idx = gt; idx < M * D / 8; idx += NGT) {
        const f32x4 a = ((const f32x4*)A.in[0])[2 * idx], b = ((const f32x4*)A.in[0])[2 * idx + 1];
        v4u o; o.x = pk2(a[0], a[1]); o.y = pk2(a[2], a[3]); o.z = pk2(b[0], b[1]); o.w = pk2(b[2], b[3]);
        ((GAS v4u*)F.XN)[idx] = o;
    }
}

__device__ __forceinline__ void attn_naive_phase(Frame& F) {
    const int gw = F.vcu * NWAVES + F.wave, NGW = F.G * NWAVES;
    const float* ks = (const float*)(F.ws + WS_KSUM);
    for (int wu = gw; wu < BATCH * NH * (SEQ / 64); wu += NGW) {
        const int bh = wu / (SEQ / 64), qc = wu % (SEQ / 64), b = bh / NH, h = bh % NH;
        const int q = qc * 64 + F.lane, qb = (qc * 64) >> 8;
        const size_t rowq = (size_t)b * SEQ + q;
        unsigned qp[32];
        { const v4u* qg = (const v4u*)(F.QO + rowq * D + h * HD);
#pragma unroll
          for (int c = 0; c < 8; ++c) { const v4u w = qg[c]; qp[4 * c + 0] = w.x; qp[4 * c + 1] = w.y; qp[4 * c + 2] = w.z; qp[4 * c + 3] = w.w; } }
        unsigned sel = (1u << qb) - 1u;
        if (qb > 3) {
            float t0 = -INFINITY, t1 = -INFINITY, t2 = -INFINITY; int i0 = 0, i1 = 0, i2 = 0;
#pragma unroll 1
            for (int j = 0; j < qb; ++j) {
                const f32x4* k0 = opaque((const f32x4*)(ks + ((size_t)(b * 8 + j)) * 1024 + h * HD)); const f32x4* k1 = k0 + (size_t)64 * 256; float s = 0.f;
#pragma unroll
                for (int c = 0; c < 8; ++c) { const f32x4 a0 = k0[2 * c] + k1[2 * c], a1 = k0[2 * c + 1] + k1[2 * c + 1];
                    s += bflo(qp[4 * c + 0]) * a0[0] + bfhi(qp[4 * c + 0]) * a0[1] + bflo(qp[4 * c + 1]) * a0[2] + bfhi(qp[4 * c + 1]) * a0[3]
                       + bflo(qp[4 * c + 2]) * a1[0] + bfhi(qp[4 * c + 2]) * a1[1] + bflo(qp[4 * c + 3]) * a1[2] + bfhi(qp[4 * c + 3]) * a1[3]; }
                asm volatile("" : "+v"(s));
                if (s > t0) { t2 = t1; i2 = i1; t1 = t0; i1 = i0; t0 = s; i0 = j; } else if (s > t1) { t2 = t1; i2 = i1; t1 = s; i1 = j; } else if (s > t2) { t2 = s; i2 = j; }
            }
            sel = (1u << i0) | (1u << i1) | (1u << i2);
        }
        float mx = -INFINITY, l = 0.f, o[64];
#pragma unroll
        for (int d = 0; d < 64; ++d) o[d] = 0.f;
        for (int j = 0; j <= qb; ++j) {
            const bool use = (j == qb) || ((sel >> j) & 1u);
            const int kend = (j == qb) ? (qc * 64 + 64 - qb * 256) : 256;
#pragma unroll 1
            for (int kk = 0; kk < kend; ++kk) {
                const int key = j * 256 + kk;
                const v4u* kp = opaque((const v4u*)(F.KB + ((size_t)b * SEQ + key) * D + h * HD));
                float s = 0.f;
#pragma unroll
                for (int c = 0; c < 8; ++c) { const v4u w = kp[c]; s += bflo(qp[4 * c + 0]) * bflo(w.x) + bfhi(qp[4 * c + 0]) * bfhi(w.x) + bflo(qp[4 * c + 1]) * bflo(w.y) + bfhi(qp[4 * c + 1]) * bfhi(w.y)
                    + bflo(qp[4 * c + 2]) * bflo(w.z) + bfhi(qp[4 * c + 2]) * bfhi(w.z) + bflo(qp[4 * c + 3]) * bflo(w.w) + bfhi(qp[4 * c + 3]) * bfhi(w.w); }
                asm volatile("" : "+v"(s));
                const bool ok = use && (key <= q);
                const float mn = ok ? fmaxf(mx, s) : mx;
                const float a = (mn == mx) ? 1.0f : __builtin_amdgcn_exp2f(mx - mn);
                const float p = ok ? __builtin_amdgcn_exp2f(s - mn) : 0.f;
                l = l * a + p; mx = mn;
                const v4u* vp = opaque((const v4u*)(F.VB + ((size_t)b * SEQ + key) * D + h * HD));
#pragma unroll
                for (int c = 0; c < 8; ++c) { const v4u w = vp[c];
                    o[8 * c + 0] = o[8 * c + 0] * a + p * bflo(w.x); o[8 * c + 1] = o[8 * c + 1] * a + p * bfhi(w.x); o[8 * c + 2] = o[8 * c + 2] * a + p * bflo(w.y); o[8 * c + 3] = o[8 * c + 3] * a + p * bfhi(w.y);
                    o[8 * c + 4] = o[8 * c + 4] * a + p * bflo(w.z); o[8 * c + 5] = o[8 * c + 5] * a + p * bfhi(w.z); o[8 * c + 6] = o[8 * c + 6] * a + p * bflo(w.w); o[8 * c + 7] = o[8 * c + 7] * a + p * bfhi(w.w); }
            }
        }
        const float rl = 1.0f / l;
        GAS v4u* op = (GAS v4u*)(F.QO + rowq * D + h * HD);
#pragma unroll
        for (int c = 0; c < 8; ++c) { v4u w; w.x = pk2(o[8 * c + 0] * rl, o[8 * c + 1] * rl); w.y = pk2(o[8 * c + 2] * rl, o[8 * c + 3] * rl); w.z = pk2(o[8 * c + 4] * rl, o[8 * c + 5] * rl); w.w = pk2(o[8 * c + 6] * rl, o[8 * c + 7] * rl); op[c] = w; }
    }
}

__device__ __forceinline__ void resln_phase(Frame& F, const bf16* Hout, const float* g, const float* bta) {
    const int gw = F.vcu * NWAVES + F.wave, NGW = F.G * NWAVES;
    for (int row = gw; row < M; row += NGW) {
        float v[16];
#pragma unroll
        for (int hf = 0; hf < 2; ++hf) { const v4u x = *(const v4u*)(F.XN + (size_t)row * D + hf * 512 + F.lane * 8), y = *(const v4u*)(Hout + (size_t)row * D + hf * 512 + F.lane * 8);
            v[8 * hf + 0] = ALPHA * bflo(x.x) + bflo(y.x); v[8 * hf + 1] = ALPHA * bfhi(x.x) + bfhi(y.x); v[8 * hf + 2] = ALPHA * bflo(x.y) + bflo(y.y); v[8 * hf + 3] = ALPHA * bfhi(x.y) + bfhi(y.y);
            v[8 * hf + 4] = ALPHA * bflo(x.z) + bflo(y.z); v[8 * hf + 5] = ALPHA * bfhi(x.z) + bfhi(y.z); v[8 * hf + 6] = ALPHA * bflo(x.w) + bflo(y.w); v[8 * hf + 7] = ALPHA * bfhi(x.w) + bfhi(y.w); }
        float s = 0.f;
#pragma unroll
        for (int i = 0; i < 16; ++i) s += v[i];
        const float mean = wave_sum(s) * (1.f / D); float s2 = 0.f;
#pragma unroll
        for (int i = 0; i < 16; ++i) { v[i] -= mean; s2 += v[i] * v[i]; }
        const float rstd = 1.f / sqrtf(wave_sum(s2) * (1.f / D) + LN_EPS);
#pragma unroll
        for (int hf = 0; hf < 2; ++hf) { const int c0 = hf * 512 + F.lane * 8; const f32x4 g0 = *(const f32x4*)(g + c0), g1 = *(const f32x4*)(g + c0 + 4), b0 = *(const f32x4*)(bta + c0), b1 = *(const f32x4*)(bta + c0 + 4);
            v4u o; o.x = pk2(v[8 * hf + 0] * rstd * g0[0] + b0[0], v[8 * hf + 1] * rstd * g0[1] + b0[1]); o.y = pk2(v[8 * hf + 2] * rstd * g0[2] + b0[2], v[8 * hf + 3] * rstd * g0[3] + b0[3]);
            o.z = pk2(v[8 * hf + 4] * rstd * g1[0] + b1[0], v[8 * hf + 5] * rstd * g1[1] + b1[1]); o.w = pk2(v[8 * hf + 6] * rstd * g1[2] + b1[2], v[8 * hf + 7] * rstd * g1[3] + b1[3]);
            *(GAS v4u*)(F.XN + (size_t)row * D + c0) = o; }
    }
}

__device__ __forceinline__ void router_phase(Frame& F, const Args& A, int l) {
    const int rg = F.wave & 3, kh = F.wave >> 2, fr = F.lane & 15, fq = F.lane >> 4;
    const bf16* Wr = (const bf16*)(F.ws + WS_WR) + (size_t)l * 2 * NRT * D;
    LAS float* part = (LAS float*)(F.lds + RING_OFF);
    int* tok = (int*)(F.ws + WS_TOK); int* asg = (int*)(F.ws + WS_ASG); float* gate = (float*)(F.ws + WS_ASG + 128 * 1024);
    for (int rb = F.vcu; rb < M / 64; rb += F.G) {
        const int row0 = rb * 64;
        const bf16* ap = F.XN + (size_t)(row0 + rg * 16 + fr) * D + kh * 512 + fq * 8;
        const bf16* bp = Wr + (size_t)fr * D + kh * 512 + fq * 8;
        f32x4 acc[5];
#pragma unroll
        for (int nf = 0; nf < 5; ++nf) acc[nf] = (f32x4){0.f, 0.f, 0.f, 0.f};
#pragma unroll 1
        for (int ks = 0; ks < 16; ++ks) {
            const bf16x8 a = *(const bf16x8*)(ap + ks * 32);
#pragma unroll
            for (int nf = 0; nf < 5; ++nf) {
                const bf16x8 bh = *(const bf16x8*)(bp + (size_t)nf * 16 * D + ks * 32), bl = *(const bf16x8*)(bp + (size_t)(NRT + nf * 16) * D + ks * 32);
                acc[nf] = __builtin_amdgcn_mfma_f32_16x16x32_bf16(a, bh, acc[nf], 0, 0, 0);
                acc[nf] = __builtin_amdgcn_mfma_f32_16x16x32_bf16(a, bl, acc[nf], 0, 0, 0);
            }
        }
#pragma unroll
        for (int nf = 0; nf < 5; ++nf)
#pragma unroll
            for (int j = 0; j < 4; ++j) part[(kh * 64 + rg * 16 + fq * 4 + j) * NRT + nf * 16 + fr] = acc[nf][j];
        __syncthreads();
        if (F.tid < 64) {
            const int t = F.tid, token = row0 + t;
            const LAS float* p0 = part + t * NRT; const LAS float* p1 = part + (64 + t) * NRT;
            float gl[8]; float gmax = -INFINITY; int gi = 0;
#pragma unroll
            for (int j = 0; j < 8; ++j) { gl[j] = p0[j] + p1[j] + A.in[15][l * 8 + j]; if (gl[j] > gmax) { gmax = gl[j]; gi = j; } }
            float gs = 0.f;
#pragma unroll
            for (int j = 0; j < 8; ++j) gs += __expf(gl[j] - gmax);
            const float gp = 1.0f / gs;
            float v0 = -INFINITY, v1 = -INFINITY; int i0 = 0, i1 = 0;
#pragma unroll
            for (int j = 0; j < 8; ++j) { const float e = p0[8 + gi * 8 + j] + p1[8 + gi * 8 + j] + A.in[17][l * NE + gi * 8 + j];
                if (e > v0) { v1 = v0; i1 = i0; v0 = e; i0 = j; } else if (e > v1) { v1 = e; i1 = j; } }
            const float pa = 1.0f / (1.0f + __expf(v1 - v0)), pb = 1.0f - pa;
            const int e0 = gi * 8 + i0, e1 = gi * 8 + i1;
            const unsigned q0 = __hip_atomic_fetch_add((unsigned*)(F.ctl + CW_CNT + l * NE + e0), 1u, RLX_AGENT);
            const unsigned q1 = __hip_atomic_fetch_add((unsigned*)(F.ctl + CW_CNT + l * NE + e1), 1u, RLX_AGENT);
            tok[e0 * TOKCAP + q0] = token; tok[e1 * TOKCAP + q1] = token;
            asg[token * 2 + 0] = (e0 << 16) | (int)q0; asg[token * 2 + 1] = (e1 << 16) | (int)q1;
            gate[token * 2 + 0] = gp * pa; gate[token * 2 + 1] = gp * pb;
        }
        __syncthreads();
    }
}

__device__ __forceinline__ int moe_tables(Frame& F, int l) {
    LAS int* cnt = (LAS int*)(F.lds + TAB_OFF); LAS int* tstart = cnt + 64; LAS int* tile_e = cnt + 64 + 68;
    if (F.tid < 64) cnt[F.tid] = (int)__hip_atomic_load(F.ctl + CW_CNT + l * NE + F.tid, RLX_AGENT);
    __syncthreads();
    if (F.tid == 0) { int s = 0; for (int e = 0; e < NE; ++e) { tstart[e] = s; s += (cnt[e] + 255) >> 8; } tstart[NE] = s; }
    __syncthreads();
    const int ntiles = tstart[NE];
    if (F.tid < ntiles && F.tid < 256) { int e = 0; for (int k = 0; k < NE; ++k) if (tstart[k + 1] <= F.tid) e = k + 1; tile_e[F.tid] = e; }
    __syncthreads();
    return ntiles < MAXTILES ? ntiles : MAXTILES;
}
struct MoeOrder {
    int ntiles, npn, G, c; const LAS int* cnt; const LAS int* tstart; const LAS int* tile_e;
    __device__ __forceinline__ bool next(int i, pg8::Unit& u) const {
        const int L = i * G + c; if (L >= ntiles * npn) return false;
        const int tile = L / npn, pn = L % npn, e = tile_e[tile], chunk = tile - tstart[e];
        u.pm = tile; u.pn = pn; u.pb = e * npn + pn; u.gofs = e * TOKCAP + chunk * 256; const int left = cnt[e] - chunk * 256; u.gcnt = left < 256 ? left : 256; return true;
    }
};

__device__ __forceinline__ void combine_phase(Frame& F, int l, const float* g, const float* bta, bool last_layer) {
    const LAS int* tstart = (const LAS int*)(F.lds + TAB_OFF) + 64;
    const int gw = F.vcu * NWAVES + F.wave, NGW = F.G * NWAVES;
    const int* asg = (const int*)(F.ws + WS_ASG); const float* gate = (const float*)(F.ws + WS_ASG + 128 * 1024);
    for (int row = gw; row < M; row += NGW) {
        const int* ap = opaque(asg + row * 2); const float* gp = opaque(gate + row * 2);
        const int a0 = ap[0], a1 = ap[1]; const float g0 = gp[0], g1 = gp[1];
        const size_t r0 = (size_t)tstart[a0 >> 16] * 256 + (a0 & 0xffff), r1 = (size_t)tstart[a1 >> 16] * 256 + (a1 & 0xffff);
        float v[16];
#pragma unroll
        for (int hf = 0; hf < 2; ++hf) { const int c0 = hf * 512 + F.lane * 8;
            const v4u x = *(const v4u*)(F.XN + (size_t)row * D + c0), y = *(const v4u*)(F.YB + r0 * D + c0), z = *(const v4u*)(F.YB + r1 * D + c0);
            v[8 * hf + 0] = ALPHA * bflo(x.x) + g0 * bflo(y.x) + g1 * bflo(z.x); v[8 * hf + 1] = ALPHA * bfhi(x.x) + g0 * bfhi(y.x) + g1 * bfhi(z.x);
            v[8 * hf + 2] = ALPHA * bflo(x.y) + g0 * bflo(y.y) + g1 * bflo(z.y); v[8 * hf + 3] = ALPHA * bfhi(x.y) + g0 * bfhi(y.y) + g1 * bfhi(z.y);
            v[8 * hf + 4] = ALPHA * bflo(x.z) + g0 * bflo(y.z) + g1 * bflo(z.z); v[8 * hf + 5] = ALPHA * bfhi(x.z) + g0 * bfhi(y.z) + g1 * bfhi(z.z);
            v[8 * hf + 6] = ALPHA * bflo(x.w) + g0 * bflo(y.w) + g1 * bflo(z.w); v[8 * hf + 7] = ALPHA * bfhi(x.w) + g0 * bfhi(y.w) + g1 * bfhi(z.w); }
        float s = 0.f;
#pragma unroll
        for (int i = 0; i < 16; ++i) s += v[i];
        const float mean = wave_sum(s) * (1.f / D); float s2 = 0.f;
#pragma unroll
        for (int i = 0; i < 16; ++i) { v[i] -= mean; s2 += v[i] * v[i]; }
        const float rstd = 1.f / sqrtf(wave_sum(s2) * (1.f / D) + LN_EPS);
#pragma unroll
        for (int hf = 0; hf < 2; ++hf) { const int c0 = hf * 512 + F.lane * 8; const f32x4 g0v = *(const f32x4*)(g + c0), g1v = *(const f32x4*)(g + c0 + 4), b0 = *(const f32x4*)(bta + c0), b1 = *(const f32x4*)(bta + c0 + 4);
            float o[8];
#pragma unroll
            for (int i = 0; i < 4; ++i) { o[i] = v[8 * hf + i] * rstd * g0v[i] + b0[i]; o[4 + i] = v[8 * hf + 4 + i] * rstd * g1v[i] + b1[i]; }
            if (last_layer) { GAS f32x4* op = (GAS f32x4*)(F.out + (size_t)row * D + c0); op[0] = (f32x4){o[0], o[1], o[2], o[3]}; op[1] = (f32x4){o[4], o[5], o[6], o[7]}; }
            else { v4u w; w.x = pk2(o[0], o[1]); w.y = pk2(o[2], o[3]); w.z = pk2(o[4], o[5]); w.w = pk2(o[6], o[7]); *(GAS v4u*)(F.XN + (size_t)row * D + c0) = w; } }
    }
}

__device__ __forceinline__ void g2a_phase(Frame& F) {
    typedef float f32x2v __attribute__((ext_vector_type(2)));
    const int gt = F.vcu * (NWAVES * 64) + F.tid, NGT = F.G * NWAVES * 64;
    const f32x2v* vp = (const f32x2v*)(F.ws + WS_VPART); f32x2v* vs = (f32x2v*)(F.ws + WS_ASG + 256 * 1024);
    for (int row = gt; row < M; row += NGT) { float s1 = 0.f, s2 = 0.f;
        for (int i = 0; i < 48; ++i) { const f32x2v p = vp[(size_t)row * 48 + i]; s1 += p.x; s2 += p.y; }
        const float mean = s1 * (1.f / DV), var = s2 * (1.f / DV) - mean * mean;
        vs[row] = (f32x2v){mean, 1.f / sqrtf(fmaxf(var, 0.f) + LN_EPS)}; }
}
__device__ __forceinline__ void g2b_naive_phase(Frame& F, const Args& A, int j) {
    typedef float f32x2v __attribute__((ext_vector_type(2)));
    const int gt = F.vcu * (NWAVES * 64) + F.tid, NGT = F.G * NWAVES * 64;
    const f32x2v* vs = (const f32x2v*)(F.ws + WS_ASG + 256 * 1024);
    const float* lg = A.in[5] + (size_t)j * DV; const float* lb = A.in[6] + (size_t)j * DV;
    const float* Ws = A.in[7] + (size_t)j * GG * CHK * CHK; const float* bs = A.in[8] + (size_t)j * GG * CHK;
    for (int id = gt; id < M * (DV / 8); id += NGT) {
        const int row = id / (DV / 8), k0 = (id % (DV / 8)) * 8, g = k0 / GD, t = row & (CHK - 1), r0 = row - t;
        float gk[8], bk[8], acc[8];
#pragma unroll
        for (int i = 0; i < 8; ++i) { gk[i] = lg[k0 + i]; bk[i] = lb[k0 + i]; acc[i] = 0.f; }
        const float* wrow = Ws + ((size_t)g * CHK + t) * CHK;
        for (int s = 0; s <= t; ++s) {
            const float w = wrow[s]; const f32x2v st = vs[r0 + s];
            const v4u vv = *(const v4u*)(F.VVB + (size_t)(r0 + s) * DV + k0);
            const float ws_ = w * st.y;
            acc[0] += ws_ * (bflo(vv.x) - st.x) * gk[0] + w * bk[0]; acc[1] += ws_ * (bfhi(vv.x) - st.x) * gk[1] + w * bk[1];
            acc[2] += ws_ * (bflo(vv.y) - st.x) * gk[2] + w * bk[2]; acc[3] += ws_ * (bfhi(vv.y) - st.x) * gk[3] + w * bk[3];
            acc[4] += ws_ * (bflo(vv.z) - st.x) * gk[4] + w * bk[4]; acc[5] += ws_ * (bfhi(vv.z) - st.x) * gk[5] + w * bk[5];
            acc[6] += ws_ * (bflo(vv.w) - st.x) * gk[6] + w * bk[6]; acc[7] += ws_ * (bfhi(vv.w) - st.x) * gk[7] + w * bk[7];
        }
        const float bt = bs[g * CHK + t];
        const v4u uu = *(const v4u*)(F.UB + (size_t)row * DV + k0);
        v4u o; o.x = pk2(bflo(uu.x) * (acc[0] + bt), bfhi(uu.x) * (acc[1] + bt)); o.y = pk2(bflo(uu.y) * (acc[2] + bt), bfhi(uu.y) * (acc[3] + bt));
        o.z = pk2(bflo(uu.z) * (acc[4] + bt), bfhi(uu.z) * (acc[5] + bt)); o.w = pk2(bflo(uu.w) * (acc[6] + bt), bfhi(uu.w) * (acc[7] + bt));
        *(GAS v4u*)(F.UB + (size_t)row * DV + k0) = o;
    }
}

constexpr int NPHASES = 1 + 2 * 8 + 2 * 9;
#ifndef MK_N_LAUNCHES
#define MK_N_LAUNCHES 1
#endif
#ifndef PG8_SP2
#define PG8_SP2 false
#endif
#ifndef DBG_QKV
#define DBG_QKV(...) __VA_ARGS__
#endif
#ifndef DBG_G1
#define DBG_G1(...) __VA_ARGS__
#endif
#ifndef DBG_WO
#define DBG_WO(...) __VA_ARGS__
#endif
#ifndef DBG_M1
#define DBG_M1(...) __VA_ARGS__
#endif
#ifndef DBG_M2
#define DBG_M2(...) __VA_ARGS__
#endif
#ifndef DBG_ATTN
#define DBG_ATTN(x) x
#endif
#ifndef DBG_G2B
#define DBG_G2B(x) x
#endif
#ifndef DBG_RT
#define DBG_RT(x) x
#endif
#ifndef DBG_P0
#define DBG_P0(x) x
#endif
#define MKFRAME() \
        unsigned char* ws; \
        { unsigned long long w = (unsigned long long)args.ws; unsigned wl = (unsigned)w, wh = (unsigned)(w >> 32); \
          asm volatile("" : "+v"(wl), "+v"(wh)); \
          wl = __builtin_amdgcn_readfirstlane(wl); wh = __builtin_amdgcn_readfirstlane(wh); \
          ws = (unsigned char*)(((unsigned long long)wh << 32) | wl); } \
        int tid_; asm volatile("v_mbcnt_lo_u32_b32 %0, -1, 0\n\tv_mbcnt_hi_u32_b32 %0, -1, %0" : "=&v"(tid_)); tid_ += wave0_ * 64; \
        Frame F; \
        F.lds = (LAS unsigned char*)lds; \
        F.MISC = (volatile LAS unsigned*)(F.lds + MISC_OFF); \
        F.tid = tid_; F.lane = F.tid & 63; F.wave = __builtin_amdgcn_readfirstlane(F.tid >> 6); \
        F.G = gridDim.x; { const int bx = blockIdx.x; F.vcu = (F.G % 8 == 0) ? (bx % 8) * (F.G / 8) + bx / 8 : bx; } \
        F.ws = ws; F.out = args.out; \
        F.ctl = (gu32*)(ws + WS_CTL); \
        F.XN = (bf16*)(ws + WS_XN); F.QO = (bf16*)(ws + WS_QO); F.KB = (bf16*)(ws + WS_K); F.VB = (bf16*)(ws + WS_V); F.UB = (bf16*)(ws + WS_U); F.VVB = (bf16*)(ws + WS_VV); \
        F.HB = (bf16*)(ws + WS_HB); F.YB = (bf16*)(ws + WS_YB);
__global__ void __launch_bounds__(NWAVES * 64, 2) fwd_kernel(Args args) {
    extern __shared__ __attribute__((aligned(16))) unsigned char lds[];
    for (int u = threadIdx.x; u < (LDS_BYTES - LDSCTL_OFF) / 4; u += NWAVES * 64) ((LAS unsigned*)((LAS unsigned char*)lds + LDSCTL_OFF))[u] = 0u;
    __syncthreads();
    const int lo = args.ph_lo, hi = args.ph_hi;
    const int wave0_ = __builtin_amdgcn_readfirstlane(threadIdx.x >> 6);
    XcdBarrier bar; bar.bar = (unsigned*)(args.ws + WS_CTL) + CW_BAR; bar.x = 0; bar.st = nullptr;
    if (hi - lo > 1) bar = xcd_barrier_post((unsigned*)(args.ws + WS_CTL) + CW_BAR, (volatile LAS unsigned*)((LAS unsigned char*)lds + MISC_OFF) + 8);
    for (int pk = lo; pk < hi; ++pk) {
        int kind = 0, l = 0;
        if (pk > 0) { const int p = pk - 1, pair = p / 17, r = p % 17;
            if (r < 8) { l = 2 * pair; kind = (r == 0) ? 1 : (r == 1) ? 2 : r + 4; }
            else { l = 2 * pair + 1; kind = (r - 8) + 3; } }
        const int j = l >> 1;
        if (kind == 0) { MKFRAME(); DBG_P0(p0_prologue(F, args)); }
        else if (kind == 1) { MKFRAME(); pg8::Gemm g{F.XN, (const bf16*)(ws + WS_WQKV) + (size_t)j * NQKV * D, M, NQKV, D, nullptr}; pg8::StaticOrder S; S.init(M, NQKV, F.G, (int)blockIdx.x);
            pg8::EpiBf16<0, 1> E{F.QO, D, nullptr, D, (size_t)(WS_K - WS_QO) / 2, QSCALE, (float*)(ws + WS_KSUM)};
            DBG_QKV(pg8::gemm_phase<pg8::EpiBf16<0, 1>, pg8::StaticOrder, true, PG8_SP2, false>(F.lds + RING_OFF, g, S, E, F.tid)); }
#if defined(ATTN_NAIVE)
        else if (kind == 2) { MKFRAME(); DBG_ATTN(attn_naive_phase(F)); }
#else
        else if (kind == 2) { MKFRAME(); const attn_body::AttnTensors AT{(const attn_body::bf16*)F.QO, (const attn_body::bf16*)F.KB, (const attn_body::bf16*)F.VB, (attn_body::bf16*)F.QO, (const float*)(ws + WS_KSUM)};
            const attn_body::MobaOrder S{F.vcu};
            DBG_ATTN(attn_body::attn_phase<attn_body::MobaOrder>((char*)lds + RING_OFF, AT, S, F.tid)); }
#endif
        else if (kind == 3) { MKFRAME(); pg8::Gemm g{F.XN, (const bf16*)(ws + WS_WIN) + (size_t)j * NZ * D, M, NZ, D, nullptr}; pg8::StaticOrder S; S.init(M, NZ, F.G, (int)blockIdx.x);
            pg8::EpiBf16<1, 2> E{F.UB, DV, args.in[4] + (size_t)j * NZ, DV, (size_t)(WS_VV - WS_U) / 2, 1.0f, (float*)(ws + WS_VPART)};
            DBG_G1(pg8::gemm_phase<pg8::EpiBf16<1, 2>, pg8::StaticOrder, true, PG8_SP2, false>(F.lds + RING_OFF, g, S, E, F.tid)); }
        else if (kind == 4) { MKFRAME(); g2a_phase(F); }
        else if (kind == 5) { MKFRAME(); DBG_G2B(g2b_naive_phase(F, args, j)); }
        else if (kind == 6) { MKFRAME(); pg8::Gemm g; if ((l & 1) == 0) g = pg8::Gemm{F.QO, (const bf16*)(ws + WS_WO) + (size_t)j * D * D, M, D, D, nullptr}; else g = pg8::Gemm{F.UB, (const bf16*)(ws + WS_WOUT) + (size_t)j * D * DV, M, D, DV, nullptr};
            pg8::StaticOrder S; S.init(M, D, F.G, (int)blockIdx.x);
            pg8::EpiBf16<0, 0> E{F.YB, D, nullptr, 0, 0, 1.0f, nullptr};
            DBG_WO(pg8::gemm_phase<pg8::EpiBf16<0, 0>, pg8::StaticOrder, true, PG8_SP2, false>(F.lds + RING_OFF, g, S, E, F.tid)); }
        else if (kind == 7) { MKFRAME(); resln_phase(F, F.YB, args.in[10] + (size_t)l * D, args.in[11] + (size_t)l * D); }
        else if (kind == 8) { MKFRAME(); DBG_RT(router_phase(F, args, l)); }
        else if (kind == 9) { MKFRAME(); const int ntiles = moe_tables(F, l); const LAS int* tb = (const LAS int*)(F.lds + TAB_OFF);
            pg8::Gemm g{F.XN, (const bf16*)(ws + WS_W13) + (size_t)l * NE * 512 * D, M, 512, D, (const int*)(ws + WS_TOK)};
            MoeOrder S{ntiles, 2, F.G, F.vcu, tb, tb + 64, tb + 64 + 68};
            pg8::EpiMoe1 E{F.HB};
            DBG_M1(pg8::gemm_phase<pg8::EpiMoe1, MoeOrder, true, PG8_SP2, true>(F.lds + RING_OFF, g, S, E, F.tid)); }
        else if (kind == 10) { MKFRAME(); const int ntiles = moe_tables(F, l); const LAS int* tb = (const LAS int*)(F.lds + TAB_OFF);
            pg8::Gemm g{F.HB, (const bf16*)(ws + WS_W2) + (size_t)l * NE * D * FE, MAXTILES * 256, D, FE, nullptr};
            MoeOrder S{ntiles, 4, F.G, F.vcu, tb, tb + 64, tb + 64 + 68};
            pg8::EpiBf16<0, 0> E{F.YB, D, nullptr, 0, 0, 1.0f, nullptr};
            DBG_M2(pg8::gemm_phase<pg8::EpiBf16<0, 0>, MoeOrder, true, PG8_SP2, false>(F.lds + RING_OFF, g, S, E, F.tid)); }
        else { MKFRAME(); (void)moe_tables(F, l); combine_phase(F, l, args.in[12] + (size_t)l * D, args.in[13] + (size_t)l * D, l == DEPTH - 1); }
        if (pk + 1 < hi) xcd_barrier(bar);
    }
}

extern "C" void kernel_launch(void* const* d_in, const int* in_sizes, int n_in, void* d_out, int out_size, void* d_ws, size_t ws_size, hipStream_t stream) {
    static int grid = 0;
    if (grid == 0) {
        if (n_in != 21 || in_sizes[0] != M * D || out_size != M * D || ws_size < WS_END) { fprintf(stderr, "kernel_launch: unexpected shapes (n_in %d, in0 %d, out %d, ws %zu); nothing launched\n", n_in, n_in > 0 ? in_sizes[0] : -1, out_size, ws_size); grid = -1; return; }
        int dev = 0, cus = 0, per_cu = 0;
        if (hipGetDevice(&dev) != hipSuccess || hipDeviceGetAttribute(&cus, hipDeviceAttributeMultiprocessorCount, dev) != hipSuccess) { fprintf(stderr, "kernel_launch: device query failed\n"); grid = -1; return; }
        if (hipFuncSetAttribute((const void*)fwd_kernel, hipFuncAttributeMaxDynamicSharedMemorySize, LDS_BYTES) != hipSuccess) { fprintf(stderr, "kernel_launch: hipFuncSetAttribute failed\n"); grid = -1; return; }
        if (hipOccupancyMaxActiveBlocksPerMultiprocessor(&per_cu, (const void*)fwd_kernel, NWAVES * 64, LDS_BYTES) != hipSuccess || per_cu < 1)
            fprintf(stderr, "kernel_launch: note: occupancy query reports %d workgroups per CU\n", per_cu);
        (void)hipGetLastError();
        grid = cus;
        if (grid != 256) fprintf(stderr, "kernel_launch: %d CUs; this build expects 256\n", grid);
    }
    if (grid < 0) return;
    if (hipMemsetAsync((char*)d_ws + WS_CTL, 0, CTL_ZERO_BYTES, stream) != hipSuccess) { fprintf(stderr, "kernel_launch: hipMemsetAsync failed\n"); return; }
    Args a{};
    for (int i = 0; i < 21; ++i) a.in[i] = (const float*)d_in[i];
    a.out = (float*)d_out; a.ws = (unsigned char*)d_ws;
    constexpr int NL = MK_N_LAUNCHES;
    for (int li = 0; li < NL; ++li) {
        if (NL == 1) { a.ph_lo = 0; a.ph_hi = NPHASES; } else { a.ph_lo = li; a.ph_hi = li + 1; }
        hipLaunchKernelGGL(fwd_kernel, dim3(grid), dim3(NWAVES * 64), LDS_BYTES, stream, a);
        const hipError_t le = hipPeekAtLastError();
        if (le != hipSuccess) { fprintf(stderr, "kernel_launch: launch %d failed: %s\n", li, hipGetErrorName(le)); break; }
    }
}
```

```cpp
#include <hip/hip_runtime.h>
#include <hip/hip_bf16.h>
#include <cstdio>
#include <cstdint>
#include <cmath>
namespace pg8 {
#define PG8_LAS __attribute__((address_space(3)))
typedef unsigned short bf16_t;
typedef short bf16x8 __attribute__((ext_vector_type(8)));
typedef float f32x4 __attribute__((ext_vector_type(4)));
typedef unsigned u32x4 __attribute__((ext_vector_type(4)));
typedef unsigned u32x2 __attribute__((ext_vector_type(2)));
constexpr int BM = 256, BK = 64, HALF = 128, HTB = HALF * BK * 2  , STAGE_BYTES = 8 * HTB, NXCD = 8, WGM = 8;

__host__ __device__ __forceinline__ int lds_byte(int r, int c) { const int st = (r >> 4) * 2 + (c >> 5), rr = r & 15, cc = c & 31, ob = rr * 64 + cc * 2; return st * 1024 + (ob ^ (((ob >> 9) & 1) << 5)); }
__host__ __device__ __forceinline__ void stage_rc(int b, int& R, int& C) { const int st = b / 1024, sb = b % 1024, swz = sb ^ (((sb >> 9) & 1) << 5); R = (st >> 1) * 16 + swz / 64; C = (st & 1) * 32 + (swz % 64) / 2; }
__host__ __device__ __forceinline__ int perm32(int rho) { const int n = rho >> 4, i = rho & 15; return 8 * (i >> 2) + 4 * n + (i & 3); }

struct Unit { int pm, pn, pb, gofs, gcnt; };
struct Gemm { const bf16_t* A; const bf16_t* Bt; int M, N, K; const int* rows; };

struct StaticOrder {
    int nM, nN, nwg, G, c;
    __host__ __device__ void init(int M, int N, int G_, int c_) { nM = M / BM; nN = N / BM; nwg = nM * nN; G = G_; c = c_; }
    __host__ __device__ bool next(int i, Unit& u) const {
        const long L = (long)i * G + c; if (L >= nwg) return false;
        int wgid = (int)L; { const int q = nwg / NXCD, r = nwg % NXCD, xcd = wgid % NXCD, off = wgid / NXCD; wgid = (xcd < r ? xcd * (q + 1) : r * (q + 1) + (xcd - r) * q) + off; }
        const int nig = WGM * nN, gid = wgid / nig, fm = gid * WGM, gsz = (nM - fm) < WGM ? (nM - fm) : WGM;
        u.pm = fm + ((wgid % nig) % gsz); u.pn = (wgid % nig) / gsz; u.pb = u.pn; u.gofs = 0; u.gcnt = 0; return true;
    }
};

__device__ __forceinline__ unsigned cvt_pk_bf16(float lo, float hi) { unsigned r; asm volatile("v_cvt_pk_bf16_f32 %0, %1, %2" : "=v"(r) : "v"(lo), "v"(hi)); return r; }
typedef float f32x2 __attribute__((ext_vector_type(2)));
__device__ __forceinline__ f32x2 gelu_pk(f32x2 v) {
    const f32x2 av = __builtin_elementwise_abs(v), d = av * 0.2316418882f + 1.0f;
    f32x2 t; t.x = __builtin_amdgcn_rcpf(d.x); t.y = __builtin_amdgcn_rcpf(d.y);
    f32x2 q = t * 0.5307027145f + (-0.7265760135f); q = q * t + 0.7107068705f; q = q * t + (-0.142248368f); q = q * t + 0.127414796f; q = q * t;
    const f32x2 s = (v * v) * (-0.72134752044f);
    f32x2 e; e.x = __builtin_amdgcn_exp2f(s.x); e.y = __builtin_amdgcn_exp2f(s.y);
    const f32x2 m = v * (q * e), r = v - m;
    f32x2 o; o.x = v.x < 0.f ? m.x : r.x; o.y = v.y < 0.f ? m.y : r.y; return o;
}

template <int ACT, int EXTRA> struct EpiBf16 {
    static constexpr bool PERM = true, AFTER_DRAIN = false; static_assert(ACT == 0 || ACT == 1, "EpiBf16: ACT is 0 (none) or 1 (gelu_pk)");
    bf16_t* O; int ldc; const float* bias; int split_cols; size_t split_stride; float scale0; float* xtra;
    __device__ __forceinline__ void operator()(const f32x4 (&acc)[2][2][4][2], const Unit& u, int wr, int wc, int fr, int fq) const {
        const int row0 = u.pm * BM + wr * 64 + fr; int colt = u.pn * BM; bf16_t* base = O;
        float sc = 1.f; if (split_cols) { const int t = colt / split_cols; base += (size_t)t * split_stride; colt -= t * split_cols; if (t == 0) sc = scale0; }
        const int col0 = colt + wc * 32 + 8 * fq, bcol0 = u.pn * BM + wc * 32 + 8 * fq;
        f32x4 bv[2][2];
#pragma unroll
        for (int bj = 0; bj < 2; ++bj)
#pragma unroll
            for (int n = 0; n < 2; ++n) bv[bj][n] = bias ? *(const f32x4*)(bias + bcol0 + bj * HALF + 4 * n) : (f32x4){0.f, 0.f, 0.f, 0.f};
        f32x4 cs[2][2];
        if (EXTRA == 1) {
#pragma unroll
            for (int bj = 0; bj < 2; ++bj)
#pragma unroll
                for (int n = 0; n < 2; ++n) cs[bj][n] = (f32x4){0.f, 0.f, 0.f, 0.f};
        }
        const bool vt = (EXTRA == 2) && (u.pn >= 12);
#pragma unroll
        for (int ai = 0; ai < 2; ++ai)
#pragma unroll
            for (int m = 0; m < 4; ++m) { bf16_t* rowp = base + (size_t)(row0 + ai * HALF + m * 16) * ldc + col0;
                float s1 = 0.f, s2 = 0.f;
#pragma unroll
                for (int bj = 0; bj < 2; ++bj) { f32x4 v0 = acc[ai][bj][m][0] + bv[bj][0], v1 = acc[ai][bj][m][1] + bv[bj][1];
                    if (ACT == 1) { f32x2 a = gelu_pk((f32x2){v0[0], v0[1]}), b = gelu_pk((f32x2){v0[2], v0[3]}), c = gelu_pk((f32x2){v1[0], v1[1]}), d = gelu_pk((f32x2){v1[2], v1[3]});
                        v0 = (f32x4){a.x, a.y, b.x, b.y}; v1 = (f32x4){c.x, c.y, d.x, d.y}; }
                    if (EXTRA == 1) { cs[bj][0] += v0; cs[bj][1] += v1; }
                    if (EXTRA == 2) { s1 += ((v0[0] + v0[1]) + (v0[2] + v0[3])) + ((v1[0] + v1[1]) + (v1[2] + v1[3]));
                                      s2 += ((v0[0] * v0[0] + v0[1] * v0[1]) + (v0[2] * v0[2] + v0[3] * v0[3])) + ((v1[0] * v1[0] + v1[1] * v1[1]) + (v1[2] * v1[2] + v1[3] * v1[3])); }
                    v0 = v0 * sc; v1 = v1 * sc; u32x4 w; w.x = cvt_pk_bf16(v0[0], v0[1]); w.y = cvt_pk_bf16(v0[2], v0[3]); w.z = cvt_pk_bf16(v1[0], v1[1]); w.w = cvt_pk_bf16(v1[2], v1[3]);
                    *(u32x4*)(rowp + bj * HALF) = w; }
                if (EXTRA == 2) { if (vt) { s1 += __shfl_xor(s1, 16); s1 += __shfl_xor(s1, 32); s2 += __shfl_xor(s2, 16); s2 += __shfl_xor(s2, 32);
                    if (fq == 0) *(f32x2*)(xtra + ((size_t)(row0 + ai * HALF + m * 16) * 48 + (u.pn - 12) * 4 + wc) * 2) = (f32x2){s1, s2}; } }
            }
        if (EXTRA == 1) { if (u.pn >= 4 && u.pn < 8) {
#pragma unroll
            for (int bj = 0; bj < 2; ++bj)
#pragma unroll
                for (int n = 0; n < 2; ++n) { f32x4 s = cs[bj][n];
#pragma unroll
                    for (int o = 1; o < 16; o <<= 1) { s[0] += __shfl_xor(s[0], o); s[1] += __shfl_xor(s[1], o); s[2] += __shfl_xor(s[2], o); s[3] += __shfl_xor(s[3], o); }
                    if (fr == 0) *(f32x4*)(xtra + ((size_t)wr * (16384 / 256) + u.pm) * 1024 + (u.pn - 4) * BM + bj * HALF + wc * 32 + 8 * fq + 4 * n) = s; } } }
    }
};

struct EpiMoe1 {
    static constexpr bool PERM = true, AFTER_DRAIN = false;
    bf16_t* Hb;
    __device__ __forceinline__ void operator()(const f32x4 (&acc)[2][2][4][2], const Unit& u, int wr, int wc, int fr, int fq) const {
        const int row0 = u.pm * BM + wr * 64 + fr, col0 = u.pn * HALF + wc * 32 + 8 * fq;
#pragma unroll
        for (int ai = 0; ai < 2; ++ai)
#pragma unroll
            for (int m = 0; m < 4; ++m) { bf16_t* rowp = Hb + (size_t)(row0 + ai * HALF + m * 16) * 256 + col0; float h[8];
#pragma unroll
                for (int n = 0; n < 2; ++n)
#pragma unroll
                    for (int j = 0; j < 4; ++j) { const float g = acc[ai][0][m][n][j], up = acc[ai][1][m][n][j];
                        h[n * 4 + j] = g * __builtin_amdgcn_rcpf(1.0f + __builtin_amdgcn_exp2f(-1.4426950408889634f * g)) * up; }
                u32x4 w; w.x = cvt_pk_bf16(h[0], h[1]); w.y = cvt_pk_bf16(h[2], h[3]); w.z = cvt_pk_bf16(h[4], h[5]); w.w = cvt_pk_bf16(h[6], h[7]);
                *(u32x4*)rowp = w; }
    }
};

struct PanelStats {
    unsigned* xbuf;
    unsigned* cnt;
    unsigned* tmo;
    int ntn; float eps; unsigned code;
    __device__ __forceinline__ bool run(const f32x4 (&v)[2][2][4][2], const Unit& u, int wr, int wc, int fr, int fq, PG8_LAS unsigned char* lds, int wid, int lane) const {
        typedef float f32x2v __attribute__((ext_vector_type(2)));
        PG8_LAS f32x2v* P = (PG8_LAS f32x2v*)lds;
        PG8_LAS f32x2v* S = (PG8_LAS f32x2v*)(lds + 8192);
        PG8_LAS unsigned* flag = (PG8_LAS unsigned*)(lds + 8192 + 2048);
#pragma unroll
        for (int ai = 0; ai < 2; ++ai)
#pragma unroll
            for (int m = 0; m < 4; ++m) {
                float s = 0.f;
#pragma unroll
                for (int bj = 0; bj < 2; ++bj)
#pragma unroll
                    for (int n = 0; n < 2; ++n) { const f32x4 x = v[ai][bj][m][n]; s += (x[0] + x[1]) + (x[2] + x[3]); }
                s += __shfl_xor(s, 16); s += __shfl_xor(s, 32);
                const float mw = s * (1.0f / 64.0f); float q = 0.f;
#pragma unroll
                for (int bj = 0; bj < 2; ++bj)
#pragma unroll
                    for (int n = 0; n < 2; ++n) { const f32x4 d = v[ai][bj][m][n] - mw; q += (d[0] * d[0] + d[1] * d[1]) + (d[2] * d[2] + d[3] * d[3]); }
                q += __shfl_xor(q, 16); q += __shfl_xor(q, 32);
                if (fq == 0) P[(ai * HALF + wr * 64 + m * 16 + fr) * 4 + wc] = (f32x2v){mw, q};
            }
        asm volatile("s_waitcnt lgkmcnt(0)" ::: "memory"); __builtin_amdgcn_s_barrier(); asm volatile("" ::: "memory");
        const int row = wid * 32 + (lane & 31);
        if (lane < 32) {
            const f32x2v a = P[row * 4 + 0], b = P[row * 4 + 1], c = P[row * 4 + 2], d = P[row * 4 + 3];
            const float mt = (a.x + b.x + c.x + d.x) * 0.25f;
            const float da = a.x - mt, db = b.x - mt, dc = c.x - mt, dd = d.x - mt;
            const float m2 = (a.y + b.y) + (c.y + d.y) + 64.0f * ((da * da + db * db) + (dc * dc + dd * dd));
            unsigned long long* slot = (unsigned long long*)xbuf + ((size_t)(u.pm * BM + row) * 4 + u.pn);
            __hip_atomic_store(slot, ((unsigned long long)__float_as_uint(m2) << 32) | __float_as_uint(mt), __ATOMIC_RELAXED, __HIP_MEMORY_SCOPE_AGENT);
        }
        asm volatile("s_waitcnt vmcnt(0)" ::: "memory");
        if (lane == 0) __hip_atomic_fetch_add(cnt + 64 * u.pm, 1u, __ATOMIC_RELAXED, __HIP_MEMORY_SCOPE_AGENT);
        if (wid == 0) {
            bool dead = false; const unsigned long long t0 = __builtin_amdgcn_s_memrealtime(); const unsigned want = 8u * (unsigned)ntn;
            for (;;) {
                if ((unsigned)__builtin_amdgcn_readfirstlane(__hip_atomic_load(cnt + 64 * u.pm, __ATOMIC_RELAXED, __HIP_MEMORY_SCOPE_AGENT)) >= want) break;
                if (__builtin_amdgcn_s_memrealtime() - t0 > 2000000ull) {
                    if (lane == 0) { unsigned expect = 0u; __hip_atomic_compare_exchange_strong(tmo + 1, &expect, code | (unsigned)(u.pm & 0xff), __ATOMIC_RELAXED, __ATOMIC_RELAXED, __HIP_MEMORY_SCOPE_AGENT);
                                     __hip_atomic_store(tmo, 1u, __ATOMIC_RELAXED, __HIP_MEMORY_SCOPE_AGENT); }
                    dead = true; break; }
                __builtin_amdgcn_s_sleep(2);
            }
            __builtin_amdgcn_fence(__ATOMIC_ACQUIRE, "agent");
            if (lane == 0) flag[0] = dead ? 1u : 0u;
        }
        asm volatile("s_waitcnt vmcnt(0) lgkmcnt(0)" ::: "memory"); __builtin_amdgcn_s_barrier(); asm volatile("" ::: "memory");
        const bool bad = flag[0] != 0u;
        if (lane < 32) {
            const unsigned long long* slot = (const unsigned long long*)xbuf + (size_t)(u.pm * BM + row) * 4; float mt[4], m2[4]; float ms = 0.f;
#pragma unroll
            for (int t = 0; t < 4; ++t) { if (t < ntn) { const unsigned long long w = __hip_atomic_load(slot + t, __ATOMIC_RELAXED, __HIP_MEMORY_SCOPE_AGENT); mt[t] = __uint_as_float((unsigned)w); m2[t] = __uint_as_float((unsigned)(w >> 32)); } else { mt[t] = 0.f; m2[t] = 0.f; } ms += mt[t]; }
            const float mean = ms / (float)ntn; float q = 0.f;
#pragma unroll
            for (int t = 0; t < 4; ++t) if (t < ntn) { const float dm = mt[t] - mean; q += m2[t] + 256.0f * dm * dm; }
            S[row] = (f32x2v){mean, 1.0f / sqrtf(q / (256.0f * (float)ntn) + eps)};
        }
        asm volatile("s_waitcnt lgkmcnt(0)" ::: "memory"); __builtin_amdgcn_s_barrier(); asm volatile("" ::: "memory");
        return bad;
    }
};
struct EpiLn1 {
    static constexpr bool PERM = false, AFTER_DRAIN = true;
    bf16_t* X; const float* gamma; const float* beta; float alpha; PanelStats st;
    __device__ __forceinline__ void fused(f32x4 (&acc)[2][2][4][2], const Unit& u, int wr, int wc, int fr, int fq, PG8_LAS unsigned char* lds, int wid, int lane) const {
        typedef float f32x2v __attribute__((ext_vector_type(2)));
        const PG8_LAS f32x2v* S = (const PG8_LAS f32x2v*)(lds + 8192);
        const int col0 = u.pn * BM + wc * 32 + 4 * fq;
#pragma unroll
        for (int ai = 0; ai < 2; ++ai)
#pragma unroll
            for (int m = 0; m < 4; ++m) { const size_t off = (size_t)(u.pm * BM + ai * HALF + wr * 64 + m * 16 + fr) * 1024 + col0;
#pragma unroll
                for (int bj = 0; bj < 2; ++bj)
#pragma unroll
                    for (int n = 0; n < 2; ++n) { const u32x2 b = *(const u32x2*)(X + off + bj * HALF + n * 16);
                        const f32x4 bs = (f32x4){__uint_as_float(b.x << 16), __uint_as_float(b.x & 0xffff0000u), __uint_as_float(b.y << 16), __uint_as_float(b.y & 0xffff0000u)};
                        acc[ai][bj][m][n] += bs * alpha; }
                if (m & 1) asm volatile("" ::: "memory"); }
        (void)st.run(acc, u, wr, wc, fr, fq, lds, wid, lane);
        f32x4 gv[2][2], bv[2][2];
#pragma unroll
        for (int bj = 0; bj < 2; ++bj)
#pragma unroll
            for (int n = 0; n < 2; ++n) { gv[bj][n] = *(const f32x4*)(gamma + col0 + bj * HALF + n * 16); bv[bj][n] = *(const f32x4*)(beta + col0 + bj * HALF + n * 16); }
#pragma unroll
        for (int ai = 0; ai < 2; ++ai)
#pragma unroll
            for (int m = 0; m < 4; ++m) { const int r = ai * HALF + wr * 64 + m * 16 + fr; const f32x2v sr = S[r]; const size_t off = (size_t)(u.pm * BM + r) * 1024 + col0;
#pragma unroll
                for (int bj = 0; bj < 2; ++bj)
#pragma unroll
                    for (int n = 0; n < 2; ++n) { const f32x4 o = (acc[ai][bj][m][n] - sr.x) * sr.y * gv[bj][n] + bv[bj][n];
                        u32x2 w; w.x = cvt_pk_bf16(o[0], o[1]); w.y = cvt_pk_bf16(o[2], o[3]); *(u32x2*)(X + off + bj * HALF + n * 16) = w; } }
    }
};

template <class Epi, class Sched, bool ALIGN_EPI = false, bool SP2 = false, bool GATHER = false>
__device__ __forceinline__ void gemm_phase(PG8_LAS unsigned char* lds, const Gemm g, const Sched& S, const Epi& E, const int tid) {
    const int wid = __builtin_amdgcn_readfirstlane(tid >> 6), lane = tid & 63, wr = wid >> 2, wc = wid & 3, fr = lane & 15, fq = lane >> 4;
    const int K = g.K, nt = K / BK;
    unsigned voffA[2], voffB[2]; int gR[2], gC[2];
#pragma unroll
    for (int i = 0; i < 2; ++i) { int R, C; stage_rc(tid * 16 + i * 8192, R, C); const int Rb = Epi::PERM ? ((R & ~31) + perm32(R & 31)) : R;
        voffA[i] = (unsigned)(R * K + C) * 2u; voffB[i] = (unsigned)(Rb * K + C) * 2u; gR[i] = R; gC[i] = C; }
    const size_t kstep = (size_t)(BK * 2);
    const size_t hstep = (size_t)HALF * K * 2;
    const size_t tstep = 2 * hstep;
    const unsigned ldsw = (unsigned)wid * 1024u;
    const int aoff = lds_byte(wr * 64 + fr, fq * 8), boff = lds_byte(wc * 32 + fr, fq * 8);
    unsigned voA[2][2], voAn[2][2];
#define PG8_GOFF(vo, uu) do { if constexpr (GATHER) { _Pragma("unroll") for (int _h = 0; _h < 2; ++_h) _Pragma("unroll") for (int _i = 0; _i < 2; ++_i) { \
        const int _r = _h * HALF + gR[_i]; int _tk = 0; if (_r < (uu).gcnt) _tk = g.rows[(uu).gofs + _r]; (vo)[_h][_i] = (unsigned)(_tk * K + gC[_i]) * 2u; } } } while (0)
#define PG8_SA(b, h) (((b) * 2 + (h)) * HTB)
#define PG8_SB(b, h) ((4 + (b) * 2 + (h)) * HTB)
#define PG8_STAGE(bufoff, gbase, voff) do { _Pragma("unroll") for (int _i = 0; _i < 2; ++_i) \
        __builtin_amdgcn_global_load_lds((const unsigned*)((const char*)(gbase) + (voff)[_i]), (PG8_LAS unsigned*)(lds + (bufoff) + ldsw + _i * 8192), 16, 0, 0); } while (0)
#define PG8_STA(b, h, kp, NX) do { if constexpr (GATHER) { unsigned _o[2]; _o[0] = (NX) ? voAn[h][0] : voA[h][0]; _o[1] = (NX) ? voAn[h][1] : voA[h][1]; PG8_STAGE(PG8_SA(b, h), (kp), _o); } \
        else { PG8_STAGE(PG8_SA(b, h), (kp) + (h) * hstep, voffA); } } while (0)
#define PG8_LDA(dst, b, h) do { _Pragma("unroll") for (int m = 0; m < 4; ++m) _Pragma("unroll") for (int k = 0; k < 2; ++k) dst[m][k] = *(const PG8_LAS bf16x8*)(lds + PG8_SA(b, h) + aoff + m * 2048 + k * 1024); } while (0)
#define PG8_LDB(dst, b, h) do { _Pragma("unroll") for (int n = 0; n < 2; ++n) _Pragma("unroll") for (int k = 0; k < 2; ++k) dst[n][k] = *(const PG8_LAS bf16x8*)(lds + PG8_SB(b, h) + boff + n * 2048 + k * 1024); } while (0)
#define PG8_MMA(ai, bj, At, Bt) do { __builtin_amdgcn_s_setprio(1); _Pragma("unroll") for (int m = 0; m < 4; ++m) _Pragma("unroll") for (int n = 0; n < 2; ++n) _Pragma("unroll") for (int k = 0; k < 2; ++k) \
        acc[ai][bj][m][n] = __builtin_amdgcn_mfma_f32_16x16x32_bf16(Bt[n][k], At[m][k], acc[ai][bj][m][n], 0, 0, 0); __builtin_amdgcn_s_setprio(0); } while (0)
#define PG8_WAIT_V(n) asm volatile("s_waitcnt vmcnt(" #n ")" ::: "memory")
#define PG8_WAIT_L(n) asm volatile("s_waitcnt lgkmcnt(" #n ")" ::: "memory")
#define PG8_BAR __builtin_amdgcn_s_barrier()
#define PG8_SCHED __builtin_amdgcn_sched_barrier(0)
    Unit cur, nxt; int ui = 0;
    if (!S.next(0, cur)) return;
    f32x4 acc[2][2][4][2];
#pragma unroll
    for (int a = 0; a < 2; ++a)
#pragma unroll
        for (int b = 0; b < 2; ++b)
#pragma unroll
            for (int m = 0; m < 4; ++m)
#pragma unroll
                for (int n = 0; n < 2; ++n) acc[a][b][m][n] = (f32x4){0.f, 0.f, 0.f, 0.f};
    bf16x8 At[4][2], B0[2][2], B1[2][2];
    const char* cA = GATHER ? (const char*)g.A : (const char*)g.A + (size_t)cur.pm * tstep; const char* cB = (const char*)g.Bt + (size_t)cur.pb * tstep;
    PG8_GOFF(voA, cur);
    if constexpr (GATHER) { _Pragma("unroll") for (int _h = 0; _h < 2; ++_h) _Pragma("unroll") for (int _i = 0; _i < 2; ++_i) voAn[_h][_i] = voA[_h][_i]; }
    if constexpr (SP2) {
        PG8_STAGE(PG8_SB(0, 0), cB, voffB); PG8_STAGE(PG8_SB(0, 1), cB + hstep, voffB); PG8_STA(0, 0, cA, false); PG8_STA(0, 1, cA, false);
        if (wr == 1) PG8_BAR;
        PG8_WAIT_V(2); PG8_BAR;
        PG8_STAGE(PG8_SB(1, 0), cB + kstep, voffB); PG8_STA(1, 0, cA + kstep, false); PG8_STAGE(PG8_SB(1, 1), cB + hstep + kstep, voffB);
        PG8_WAIT_V(6); PG8_BAR;
    } else {
        PG8_STAGE(PG8_SB(0, 0), cB, voffB); PG8_STA(0, 0, cA, false); PG8_STAGE(PG8_SB(0, 1), cB + hstep, voffB); PG8_STA(0, 1, cA, false);
        if (wr == 1) PG8_BAR;
        PG8_WAIT_V(4); PG8_BAR;
        PG8_STAGE(PG8_SB(1, 0), cB + kstep, voffB); PG8_STA(1, 0, cA + kstep, false); PG8_STAGE(PG8_SB(1, 1), cB + hstep + kstep, voffB);
        PG8_WAIT_V(6); PG8_BAR;
    }
    for (;;) {
        const bool has_next = S.next(ui + 1, nxt);
        if constexpr (GATHER) { if (has_next) { PG8_GOFF(voAn, nxt); asm volatile("s_waitcnt vmcnt(0)" ::: "memory"); } }
        const char* nA = GATHER ? cA : (has_next ? (const char*)g.A + (size_t)nxt.pm * tstep : cA); const char* nB = has_next ? (const char*)g.Bt + (size_t)nxt.pb * tstep : cB;
        for (int t = 0; t < nt; t += 2) {
            const bool last = (t == nt - 2);
            const bool NX = last && has_next;
            const char* a1 = cA + (size_t)(t + 1) * kstep;
            const char* a2 = last ? nA : cA + (size_t)(t + 2) * kstep; const char* b2 = last ? nB : cB + (size_t)(t + 2) * kstep;
            const char* a3 = a2 + kstep; const char* b3 = b2 + kstep;
            if constexpr (SP2) {
            PG8_LDB(B0, 0, 0); PG8_LDB(B1, 0, 1); PG8_SCHED; PG8_LDA(At, 0, 0); PG8_STA(1, 1, a1, false);
            PG8_WAIT_V(8); PG8_WAIT_L(0); PG8_BAR; PG8_MMA(0, 0, At, B0); PG8_MMA(0, 1, At, B1); PG8_BAR; PG8_SCHED;
            PG8_LDA(At, 0, 1); PG8_STAGE(PG8_SB(0, 0), b2, voffB); PG8_STAGE(PG8_SB(0, 1), b2 + hstep, voffB); PG8_STA(0, 0, a2, NX);
            PG8_WAIT_V(8); PG8_WAIT_L(0); PG8_BAR; PG8_MMA(1, 0, At, B0); PG8_MMA(1, 1, At, B1); PG8_BAR; PG8_SCHED;
            PG8_LDB(B0, 1, 0); PG8_LDB(B1, 1, 1); PG8_SCHED; PG8_LDA(At, 1, 0); PG8_STA(0, 1, a2, NX);
            PG8_WAIT_V(8); PG8_WAIT_L(0); PG8_BAR; PG8_MMA(0, 0, At, B0); PG8_MMA(0, 1, At, B1); PG8_BAR; PG8_SCHED;
            PG8_LDA(At, 1, 1); PG8_STAGE(PG8_SB(1, 0), b3, voffB); PG8_STAGE(PG8_SB(1, 1), b3 + hstep, voffB); PG8_STA(1, 0, a3, NX);
            PG8_WAIT_V(8); PG8_WAIT_L(0); PG8_BAR; PG8_MMA(1, 0, At, B0); PG8_MMA(1, 1, At, B1); PG8_BAR; PG8_SCHED;
            } else {
            PG8_LDB(B0, 0, 0); PG8_SCHED; PG8_LDA(At, 0, 0); PG8_STA(1, 1, a1, false);
            PG8_WAIT_L(8); PG8_BAR; PG8_WAIT_L(0); PG8_MMA(0, 0, At, B0); PG8_BAR; PG8_SCHED;
            PG8_LDB(B1, 0, 1); PG8_STAGE(PG8_SB(0, 0), b2, voffB);
            PG8_BAR; PG8_WAIT_L(0); PG8_MMA(0, 1, At, B1); PG8_BAR;
            PG8_LDA(At, 0, 1); PG8_STA(0, 0, a2, NX);
            PG8_BAR; PG8_WAIT_L(0); PG8_MMA(1, 0, At, B0); PG8_BAR; PG8_SCHED;
            PG8_STAGE(PG8_SB(0, 1), b2 + hstep, voffB);
            PG8_WAIT_V(6); PG8_BAR; PG8_MMA(1, 1, At, B1); PG8_BAR;
            PG8_LDB(B0, 1, 0); PG8_SCHED; PG8_LDA(At, 1, 0); PG8_STA(0, 1, a2, NX);
            PG8_WAIT_L(8); PG8_BAR; PG8_WAIT_L(0); PG8_MMA(0, 0, At, B0); PG8_BAR; PG8_SCHED;
            PG8_LDB(B1, 1, 1); PG8_STAGE(PG8_SB(1, 0), b3, voffB);
            PG8_BAR; PG8_WAIT_L(0); PG8_MMA(0, 1, At, B1); PG8_BAR;
            PG8_LDA(At, 1, 1); PG8_STA(1, 0, a3, NX);
            PG8_BAR; PG8_WAIT_L(0); PG8_MMA(1, 0, At, B0); PG8_BAR; PG8_SCHED;
            PG8_STAGE(PG8_SB(1, 1), b3 + hstep, voffB);
            PG8_WAIT_V(6); PG8_BAR; PG8_MMA(1, 1, At, B1); PG8_BAR;
            }
        }
        if constexpr (ALIGN_EPI) { if (wr == 0) PG8_BAR; }
        if constexpr (!Epi::AFTER_DRAIN) { int t2 = tid; asm volatile("" : "+v"(t2)); const int l2 = t2 & 63; E(acc, cur, wr, wc, l2 & 15, l2 >> 4); }
        if (!has_next) break;
#pragma unroll
        for (int a = 0; a < 2; ++a)
#pragma unroll
            for (int b = 0; b < 2; ++b)
#pragma unroll
                for (int m = 0; m < 4; ++m)
#pragma unroll
                    for (int n = 0; n < 2; ++n) acc[a][b][m][n] = (f32x4){0.f, 0.f, 0.f, 0.f};
        cur = nxt; cA = nA; cB = nB; ++ui;
        if constexpr (GATHER) { _Pragma("unroll") for (int _h = 0; _h < 2; ++_h) _Pragma("unroll") for (int _i = 0; _i < 2; ++_i) voA[_h][_i] = voAn[_h][_i]; }
        if constexpr (ALIGN_EPI) { if (wr == 1) PG8_BAR; }
    }
    PG8_WAIT_V(0);
    if constexpr (!ALIGN_EPI) { if (wr == 0) PG8_BAR; }
    PG8_BAR;
    if constexpr (Epi::AFTER_DRAIN) { int t2 = tid; asm volatile("" : "+v"(t2)); const int l2 = t2 & 63; E.fused(acc, cur, wr, wc, l2 & 15, l2 >> 4, lds, wid, l2); }
#undef PG8_GOFF
#undef PG8_SA
#undef PG8_SB
#undef PG8_STAGE
#undef PG8_STA
#undef PG8_LDA
#undef PG8_LDB
#undef PG8_MMA
#undef PG8_WAIT_V
#undef PG8_WAIT_L
#undef PG8_BAR
#undef PG8_SCHED
}
}
#include <hip/hip_bf16.h>
#include <cmath>
namespace attn_body {
using bf16=__hip_bfloat16;
using bf16x8=__attribute__((ext_vector_type(8)))short;
using s16x4=__attribute__((ext_vector_type(4)))short;
using f32x16=__attribute__((ext_vector_type(16)))float;
using u32x4=__attribute__((ext_vector_type(4)))unsigned;
constexpr int BATCH=8,NHEAD=16,SEQ=2048,D=64,DM=NHEAD*D;
constexpr int NW=8,QBLK=32,QB=QBLK*NW,KVBLK=64,NQB=SEQ/QB;
constexpr int ATTN_PITCH=DM, ATTN_UNIT_ROWS=QB; constexpr int LDS_KM=98304; constexpr float NEGBIG=-1e30f;
__device__ __forceinline__ int crow(int r,int hi){return (r&3)+8*(r>>2)+4*hi;}
#define SBAR() __builtin_amdgcn_sched_barrier(0)
__device__ __forceinline__ void cmask(f32x16&p0,f32x16&p1,int jb,int qrel,int hi){
  const float NEG=-INFINITY; int kb=64*jb+4*hi;
  #pragma unroll
  for(int r=0;r<16;++r){int kv=kb+(r&3)+8*(r>>2); if(kv>qrel)p0[r]=NEG; if(kv+32>qrel)p1[r]=NEG;}
}

typedef float f32x4_t __attribute__((ext_vector_type(4)));
__device__ __forceinline__ float bf2f_(short v){return __uint_as_float(((unsigned)(unsigned short)v)<<16);}
constexpr int NSLOT=3, SLOTB=8192;
constexpr int LDS_K=0, LDS_V=NSLOT*SLOTB, LDS_WS=2*NSLOT*SLOTB, LDS_OST=LDS_WS+NW*64*4, LDS_BYTES=LDS_OST+NW*4096;
constexpr float C2=0.125f*1.4426950408889634f;
__device__ __forceinline__ void glds16(const void*gsrc,unsigned lds_dst){unsigned keep;
  asm volatile("s_mov_b32 %0, m0\n\ts_mov_b32 m0, %2\n\ts_nop 0\n\tglobal_load_lds_dwordx4 %1, off\n\ts_mov_b32 m0, %0":"=&s"(keep):"v"(gsrc),"s"(lds_dst):"memory");}
__device__ __forceinline__ float max3f(float a,float b,float c){float r;asm("v_max3_f32 %0, %1, %2, %3":"=v"(r):"v"(a),"v"(b),"v"(c));return r;}
__device__ __forceinline__ float max2f(float a,float b){float r;asm("v_max_f32_e32 %0, %1, %2":"=v"(r):"v"(a),"v"(b));return r;}
__device__ __forceinline__ float fadd_s(float a,float b){float r;asm("v_add_f32_e32 %0, %1, %2":"=v"(r):"v"(a),"v"(b));return r;}
__device__ __forceinline__ float fsub_s(float a,float b){float r;asm("v_sub_f32_e32 %0, %1, %2":"=v"(r):"v"(a),"v"(b));return r;}
typedef float f32x2_t __attribute__((ext_vector_type(2))); typedef __bf16 bf16x2_t __attribute__((ext_vector_type(2)));
__device__ __forceinline__ unsigned cvtpk_s(float lo,float hi){f32x2_t v={lo,hi};bf16x2_t b=__builtin_convertvector(v,bf16x2_t);return __builtin_bit_cast(unsigned,b);}
#define WAIT_BAR(N) asm volatile("s_waitcnt vmcnt(" #N ") lgkmcnt(0)\n\ts_barrier":::"memory")

__device__ __forceinline__ void qkt(f32x16&p0,f32x16&p1,const char*Kslot,const bf16x8*qr,const f32x16&negm,int r32,int hi){
  const char*kb=Kslot+hi*1024+r32*16;
  #pragma unroll
  for(int d0=0;d0<4;++d0){
    const bf16x8 b0=*reinterpret_cast<const bf16x8*>(kb+d0*2048);
    const bf16x8 b1=*reinterpret_cast<const bf16x8*>(kb+d0*2048+512);
    if(d0==0){p0=__builtin_amdgcn_mfma_f32_32x32x16_bf16(b0,qr[0],negm,0,0,0);p1=__builtin_amdgcn_mfma_f32_32x32x16_bf16(b1,qr[0],negm,0,0,0);}
    else{p0=__builtin_amdgcn_mfma_f32_32x32x16_bf16(b0,qr[d0],p0,0,0,0);p1=__builtin_amdgcn_mfma_f32_32x32x16_bf16(b1,qr[d0],p1,0,0,0);}}
}
typedef __attribute__((address_space(3))) const char* lds_cptr;
typedef short v4i16_t __attribute__((ext_vector_type(4)));
__device__ __forceinline__ void kload8(bf16x8*kf,lds_cptr kp){
  kf[0]=*(const __attribute__((address_space(3))) bf16x8*)(kp);      kf[1]=*(const __attribute__((address_space(3))) bf16x8*)(kp+512);
  kf[2]=*(const __attribute__((address_space(3))) bf16x8*)(kp+2048); kf[3]=*(const __attribute__((address_space(3))) bf16x8*)(kp+2560);
  kf[4]=*(const __attribute__((address_space(3))) bf16x8*)(kp+4096); kf[5]=*(const __attribute__((address_space(3))) bf16x8*)(kp+4608);
  kf[6]=*(const __attribute__((address_space(3))) bf16x8*)(kp+6144); kf[7]=*(const __attribute__((address_space(3))) bf16x8*)(kp+6656);
}
__device__ __forceinline__ void kload2(bf16x8*kf,lds_cptr kp,int j){ kf[2*j]=*(const __attribute__((address_space(3))) bf16x8*)(kp+j*2048); kf[2*j+1]=*(const __attribute__((address_space(3))) bf16x8*)(kp+j*2048+512); }
__device__ __forceinline__ s16x4 vtr(lds_cptr p){ return __builtin_bit_cast(s16x4,__builtin_amdgcn_ds_read_tr16_b64_v4i16((__attribute__((address_space(3))) v4i16_t*)p)); }
__device__ __forceinline__ float rowmax(const f32x16&p0,const f32x16&p1){
  float a=max3f(p0[0],p0[1],p1[0]),b=max3f(p0[2],p0[3],p1[1]);a=max3f(a,p1[2],p1[3]);
  #pragma unroll
  for(int r=4;r<16;r+=4){a=max3f(a,p0[r],p0[r+1]);b=max3f(b,p0[r+2],p0[r+3]);a=max3f(a,p1[r],p1[r+1]);b=max3f(b,p1[r+2],p1[r+3]);}
  const float m=max2f(a,b);
  auto rr=__builtin_amdgcn_permlane32_swap(__float_as_uint(m),__float_as_uint(m),false,false);
  return max2f(__uint_as_float(rr[0]),__uint_as_float(rr[1]));
}
__device__ __forceinline__ void pv(f32x16*o,int vb,bf16x8 pa0,bf16x8 pa1,bf16x8 pa2,bf16x8 pa3){
  #pragma unroll
  for(int d0=0;d0<2;++d0){s16x4 lo[4],hi[4];
    #pragma unroll
    for(int ks=0;ks<4;++ks){
      asm volatile("ds_read_b64_tr_b16 %0,%1 offset:%c2":"=&v"(lo[ks]):"v"(vb),"i"(d0*4096+ks*1024):"memory");
      asm volatile("ds_read_b64_tr_b16 %0,%1 offset:%c2":"=&v"(hi[ks]):"v"(vb),"i"(d0*4096+ks*1024+512):"memory");}
    asm volatile("s_waitcnt lgkmcnt(0)":::"memory");SBAR();
    #define PK(k) (bf16x8){lo[k][0],lo[k][1],lo[k][2],lo[k][3],hi[k][0],hi[k][1],hi[k][2],hi[k][3]}
    o[d0]=__builtin_amdgcn_mfma_f32_32x32x16_bf16(pa0,PK(0),o[d0],0,0,0);
    o[d0]=__builtin_amdgcn_mfma_f32_32x32x16_bf16(pa1,PK(1),o[d0],0,0,0);
    o[d0]=__builtin_amdgcn_mfma_f32_32x32x16_bf16(pa2,PK(2),o[d0],0,0,0);
    o[d0]=__builtin_amdgcn_mfma_f32_32x32x16_bf16(pa3,PK(3),o[d0],0,0,0);
    #undef PK
  }
}

#ifndef ATTN_STORE16
#define ATTN_STORE16(p,v) (*(u32x4*)(p)=(v))
#endif
template<int THRL> __device__ __forceinline__ void attn_unit(int b,int h,int qb,const bf16*Q,const bf16*__restrict__ K,const bf16*__restrict__ V,bf16*O,const float*ksum,char*shm,const int tid){
  const int lane=tid&63,r32=lane&31,hi=lane>>5; const int wid=__builtin_amdgcn_readfirstlane(tid>>6);
  const long rowbase=(long)b*SEQ; const int q0=qb*QB;
  const bf16*Qw=Q+(rowbase+q0+wid*QBLK)*DM+h*D;
  const bf16*Kh=K+rowbase*DM+h*D,*Vh=V+rowbase*DM+h*D;
  const unsigned lds0=(unsigned)(uintptr_t)shm;
  float*wsf=(float*)(shm+LDS_WS)+wid*64;
  const bf16*ksrc=Kh+(long)lane*DM+wid*8;
  const bf16*vsrc=Vh+(long)(16*(wid&3)+(lane>>2))*DM+(wid>>2)*32+(lane&3)*8;
  const unsigned kdst=lds0+LDS_K+wid*1024, vdst=lds0+LDS_V+wid*1024;
  #define KT(t) (((t)<4)?(4*qb+(t)):((t)-4))
  #define DMA_K(t,slot) glds16(ksrc+(long)KT(t)*KVBLK*DM,(unsigned)__builtin_amdgcn_readfirstlane(kdst+(slot)))
  #define DMA_V(t,slot) glds16(vsrc+(long)KT(t)*KVBLK*DM,(unsigned)__builtin_amdgcn_readfirstlane(vdst+(slot)))
  const int vb0=(int)(lds0+LDS_V)+((lane>>4)&1)*32+(lane&3)*8+(4*hi+((lane&15)>>2))*64;
  const char*Kbase=shm+LDS_K; bf16x8 kf[8];
  const lds_cptr shm3=(lds_cptr)shm; const lds_cptr kp0=shm3+LDS_K+hi*1024+r32*16; const lds_cptr vp0=shm3+LDS_V+((lane>>4)&1)*32+(lane&3)*8+(4*hi+((lane&15)>>2))*64;
  const int NT=(q0+QB)/KVBLK;
  if(qb>3&&tid<448){const int j_=tid>>6,d_=tid&63; if(j_<qb){const float*kp_=ksum+((long)(b*8+j_))*1024+h*D+d_; float a_=kp_[0]+kp_[(long)64*1024]; ((float*)(shm+LDS_KM))[tid]=a_;}}
  asm volatile("s_waitcnt vmcnt(0)":::"memory");
  DMA_K(0,0);DMA_V(0,0);DMA_K(1,SLOTB);
  bf16x8 qr[4];
  #pragma unroll
  for(int d0=0;d0<4;++d0)qr[d0]=*reinterpret_cast<const bf16x8*>(&Qw[(long)r32*DM+d0*16+hi*8]);
  float mhat=0.f,l_reg=0.f;f32x16 o[2];o[0]=f32x16{};o[1]=f32x16{};f32x16 negm=f32x16{};asm volatile("":"+v"(negm));
  const int qrel=wid*QBLK+r32;
  #define CMASK(P0,P1,t) do{ if((t)<4)cmask(P0,P1,(t),qrel,hi);}while(0)
  bool resc=false;
  #define START(P0,P1) do{ const float rm=rowmax(P0,P1); resc=false; \
    { const float dl=rm; mhat=fadd_s(mhat,dl); \
      _Pragma("unroll") for(int r=0;r<16;++r){P0[r]=fsub_s(P0[r],dl);P1[r]=fsub_s(P1[r],dl);} \
      _Pragma("unroll") for(int r=0;r<16;++r)negm[r]=-mhat; asm volatile("":"+v"(negm)); } \
    _Pragma("unroll") for(int r=0;r<16;++r)P0[r]=__builtin_amdgcn_exp2f(P0[r]); }while(0)
  #define RESC() do{ if(resc){ asm volatile("s_waitcnt lgkmcnt(0)":::"memory"); \
      _Pragma("unroll") for(int d_=0;d_<2;++d_) _Pragma("unroll") for(int r=0;r<16;++r)o[d_][r]*=wsf[crow(r,hi)]; } }while(0)
  f32x16 pA0,pA1,pB0,pB1;
  int sl_prev=0,sl_cur=0,sl_next=SLOTB;
  #define ROT() do{sl_prev=sl_cur;sl_cur=sl_next;sl_next=(sl_next==(NSLOT-1)*SLOTB)?0:sl_next+SLOTB;}while(0)
  DMA_K(2,2*SLOTB);
  WAIT_BAR(3);
  unsigned selbits=0xffu;
  if(qb>3){ float t0_=-INFINITY,t1_=-INFINITY,t2_=-INFINITY; int i0_=0,i1_=0,i2_=0; const float*kmf=(const float*)(shm+LDS_KM)+8*hi;
    _Pragma("unroll 1") for(int j_=0;j_<qb;++j_){ float s_=0.f;
      _Pragma("unroll") for(int d0=0;d0<4;++d0){ const f32x4_t ka=*(const f32x4_t*)(kmf+j_*64+d0*16), kb=*(const f32x4_t*)(kmf+j_*64+d0*16+4);
        s_+=bf2f_(qr[d0][0])*ka[0]+bf2f_(qr[d0][1])*ka[1]+bf2f_(qr[d0][2])*ka[2]+bf2f_(qr[d0][3])*ka[3]+bf2f_(qr[d0][4])*kb[0]+bf2f_(qr[d0][5])*kb[1]+bf2f_(qr[d0][6])*kb[2]+bf2f_(qr[d0][7])*kb[3]; }
      s_+=__shfl_xor(s_,32);
      if(s_>t0_){t2_=t1_;i2_=i1_;t1_=t0_;i1_=i0_;t0_=s_;i0_=j_;} else if(s_>t1_){t2_=t1_;i2_=i1_;t1_=s_;i1_=j_;} else if(s_>t2_){t2_=s_;i2_=j_;} }
    selbits=(1u<<i0_)|(1u<<i1_)|(1u<<i2_); }
  #define BSEL(t) (((t)<4)||((selbits>>(((t)-4)>>2))&1u))
  qkt(pA0,pA1,Kbase,qr,negm,r32,hi);asm volatile("s_nop 15\n\ts_nop 7":"+v"(pA0),"+v"(pA1));CMASK(pA0,pA1,0);
  START(pA0,pA1);
  _Pragma("unroll") for(int r=0;r<16;++r)pA1[r]=__builtin_amdgcn_exp2f(pA1[r]);
  WAIT_BAR(0);
  DMA_K(3,0);DMA_V(1,SLOTB);
  ROT();
  kload8(kf,kp0+sl_cur);
  WAIT_BAR(2);
  s16x4 vlo[8],vhi[8]; u32x4 pw0,pw1,pw2,pw3;
  #define PKW(P,B) cvtpk_s(P[B],P[B+1])
  #define PAF(k) __builtin_bit_cast(bf16x8,pw##k)
  #define VFR(i) (bf16x8){vlo[i][0],vlo[i][1],vlo[i][2],vlo[i][3],vhi[i][0],vhi[i][1],vhi[i][2],vhi[i][3]}
  #define PIN(x) asm volatile("":"+v"(x))
  #define MX3(a,b,c) __builtin_fmaxf(__builtin_fmaxf((a),(b)),(c))
  #define GAPA(MF,A0,A1,A2,A3,W0,W1,PW) do{ MF; sacc+=A0; sacc+=A1; sacc+=A2; sacc+=A3; PIN(sacc); W0; W1; PIN(PW); SBAR(); }while(0)
  #define EX(v) __builtin_amdgcn_exp2f(v)
  #define GAPB(MF,X,B) do{ MF; X[B]=EX(X[B]); X[B+1]=EX(X[B+1]); X[B+2]=EX(X[B+2]); X[B+3]=EX(X[B+3]); PIN(X); SBAR(); }while(0)
  #define VRD(i) do{ vlo[i]=vtr(vp_+(((i)>>2)*4096+((i)&3)*1024)); vhi[i]=vtr(vp_+(((i)>>2)*4096+((i)&3)*1024+512)); }while(0)
  #define KRD(G,j) do{ if(G){ kload2(kf,kp0+sl_next,j); SBAR(); } }while(0)
  #define STEP(C0,C1,P0,P1,t,GK,GV,GL) do{ if((((t)&3)==0)&&((t)>=4)){ const float nm_=BSEL(t)?-mhat:NEGBIG; _Pragma("unroll") for(int r=0;r<16;++r)negm[r]=nm_; asm volatile("":"+v"(negm)); } SBAR(); \
    const lds_cptr vp_=vp0+sl_prev; \
    VRD(0); SBAR(); float sacc=(P0[0]+P0[1]); \
    GAPA(C0=__builtin_amdgcn_mfma_f32_32x32x16_bf16(kf[0],qr[0],negm,0,0,0), P0[2],P0[3],P0[4],P0[5],     pw0[0]=PKW(P0,0), pw0[1]=PKW(P0,2), pw0); \
    VRD(4); SBAR(); GAPA(C1=__builtin_amdgcn_mfma_f32_32x32x16_bf16(kf[1],qr[0],negm,0,0,0), P0[6],P0[7],P0[8],P0[9],     pw0[2]=PKW(P0,4), pw0[3]=PKW(P0,6), pw0); \
    VRD(1); SBAR(); GAPA(C0=__builtin_amdgcn_mfma_f32_32x32x16_bf16(kf[2],qr[1],C0,0,0,0),   P0[10],P0[11],P0[12],P0[13], pw1[0]=PKW(P0,8), pw1[1]=PKW(P0,10), pw1); \
    VRD(5); SBAR(); GAPA(C1=__builtin_amdgcn_mfma_f32_32x32x16_bf16(kf[3],qr[1],C1,0,0,0),   P0[14],P0[15],P1[0],P1[1],   pw1[2]=PKW(P0,12),pw1[3]=PKW(P0,14), pw1); \
    VRD(2); SBAR(); GAPA(C0=__builtin_amdgcn_mfma_f32_32x32x16_bf16(kf[4],qr[2],C0,0,0,0),   P1[2],P1[3],P1[4],P1[5],     pw2[0]=PKW(P1,0), pw2[1]=PKW(P1,2), pw2); \
    VRD(6); SBAR(); GAPA(C1=__builtin_amdgcn_mfma_f32_32x32x16_bf16(kf[5],qr[2],C1,0,0,0),   P1[6],P1[7],P1[8],P1[9],     pw2[2]=PKW(P1,4), pw2[3]=PKW(P1,6), pw2); \
    VRD(3); SBAR(); GAPA(C0=__builtin_amdgcn_mfma_f32_32x32x16_bf16(kf[6],qr[3],C0,0,0,0),   P1[10],P1[11],P1[12],P1[13], pw3[0]=PKW(P1,8), pw3[1]=PKW(P1,10), pw3); \
    VRD(7); SBAR(); GAPA(C1=__builtin_amdgcn_mfma_f32_32x32x16_bf16(kf[7],qr[3],C1,0,0,0),   P1[14],P1[15],0.f,0.f,       pw3[2]=PKW(P1,12),pw3[3]=PKW(P1,14), pw3); \
    l_reg+=sacc; \
    if(GK){DMA_K((t)+3,sl_cur);} if(GV){DMA_V((t)+1,sl_next);} \
    CMASK(C0,C1,t); \
    { float a=MX3(C0[0],C0[1],C1[0]),b=MX3(C0[2],C0[3],C1[1]); a=MX3(a,C1[2],C1[3]); \
      _Pragma("unroll") for(int r=4;r<16;r+=4){a=MX3(a,C0[r],C0[r+1]);b=MX3(b,C0[r+2],C0[r+3]);a=MX3(a,C1[r],C1[r+1]);b=MX3(b,C1[r+2],C1[r+3]);} \
      float rm=__builtin_fmaxf(a,b); { auto rr=__builtin_amdgcn_permlane32_swap(__float_as_uint(rm),__float_as_uint(rm),false,false); rm=__builtin_fmaxf(__uint_as_float(rr[0]),__uint_as_float(rr[1])); } \
      resc=false; \
      if(__builtin_expect(__any(rm>(float)THRL),0)){ const float dl=__builtin_fmaxf(rm,0.f); mhat+=dl; \
        _Pragma("unroll") for(int r=0;r<16;++r){C0[r]-=dl;C1[r]-=dl;} \
        { const float nm_=BSEL((t)+1)?-mhat:NEGBIG; _Pragma("unroll") for(int r=0;r<16;++r)negm[r]=nm_; } asm volatile("":"+v"(negm)); \
        const float f=__builtin_amdgcn_exp2f(-dl); l_reg*=f; if(hi==0)wsf[r32]=f; resc=true; } } \
    SBAR(); \
    GAPB(o[0]=__builtin_amdgcn_mfma_f32_32x32x16_bf16(PAF(0),VFR(0),o[0],0,0,0), C0,0); \
    GAPB(o[1]=__builtin_amdgcn_mfma_f32_32x32x16_bf16(PAF(0),VFR(4),o[1],0,0,0), C0,4); \
    KRD(GL,0); GAPB(o[0]=__builtin_amdgcn_mfma_f32_32x32x16_bf16(PAF(1),VFR(1),o[0],0,0,0), C0,8); \
    KRD(GL,1); GAPB(o[1]=__builtin_amdgcn_mfma_f32_32x32x16_bf16(PAF(1),VFR(5),o[1],0,0,0), C0,12); \
    KRD(GL,2); GAPB(o[0]=__builtin_amdgcn_mfma_f32_32x32x16_bf16(PAF(2),VFR(2),o[0],0,0,0), C1,0); \
    KRD(GL,3); GAPB(o[1]=__builtin_amdgcn_mfma_f32_32x32x16_bf16(PAF(2),VFR(6),o[1],0,0,0), C1,4); \
    GAPB(o[0]=__builtin_amdgcn_mfma_f32_32x32x16_bf16(PAF(3),VFR(3),o[0],0,0,0), C1,8); \
    GAPB(o[1]=__builtin_amdgcn_mfma_f32_32x32x16_bf16(PAF(3),VFR(7),o[1],0,0,0), C1,12); \
    }while(0)
  int t=1;
  #define ENDW(tt) do{ if((tt)+3<NT){WAIT_BAR(2);} else if((tt)+2<NT){WAIT_BAR(1);} else {WAIT_BAR(0);} }while(0)
  #define GPAIR() do{ STEP(pB0,pB1,pA0,pA1,t,(t+3<NT),(t+1<NT),(t+1<NT));       ENDW(t);   RESC(); ROT(); \
                      STEP(pA0,pA1,pB0,pB1,t+1,(t+4<NT),(t+2<NT),(t+2<NT));     ENDW(t+1); RESC(); ROT(); }while(0)
  for(;t<5&&t+1<NT;t+=2){ GPAIR(); }
  #undef CMASK
  #define CMASK(P0,P1,t) do{}while(0)
  for(;t+5<NT;t+=2){
    STEP(pB0,pB1,pA0,pA1,t,true,true,true);     WAIT_BAR(2); RESC(); ROT();
    STEP(pA0,pA1,pB0,pB1,t+1,true,true,true);   WAIT_BAR(2); RESC(); ROT();
  }
  #undef CMASK
  #define CMASK(P0,P1,t) do{ if((t)<4)cmask(P0,P1,(t),qrel,hi);}while(0)
  for(;t+1<NT;t+=2){ GPAIR(); }
  STEP(pB0,pB1,pA0,pA1,NT-1,false,false,false); RESC();
  { float sacc=pB0[0]+pB0[1]; _Pragma("unroll") for(int r=2;r<16;++r)sacc+=pB0[r]; _Pragma("unroll") for(int r=0;r<16;++r)sacc+=pB1[r]; l_reg+=sacc;
    pw0=(u32x4){PKW(pB0,0),PKW(pB0,2),PKW(pB0,4),PKW(pB0,6)};pw1=(u32x4){PKW(pB0,8),PKW(pB0,10),PKW(pB0,12),PKW(pB0,14)};pw2=(u32x4){PKW(pB1,0),PKW(pB1,2),PKW(pB1,4),PKW(pB1,6)};pw3=(u32x4){PKW(pB1,8),PKW(pB1,10),PKW(pB1,12),PKW(pB1,14)};
    SBAR(); pv(o,vb0+sl_cur,PAF(0),PAF(1),PAF(2),PAF(3)); }
  #undef PKW
  #undef PAF
  #undef VFR
  #undef PIN
  #undef MX3
  #undef GAPA
  #undef GAPB
  #undef EX
  #undef VRD
  #undef KRD
  #undef STEP
  #undef ENDW
  #undef GPAIR
  #undef BSEL
  int hi2=hi,r32b=r32; asm volatile("":"+v"(hi2),"+v"(r32b));
  {auto rr=__builtin_amdgcn_permlane32_swap(__float_as_uint(l_reg),__float_as_uint(l_reg),false,false);l_reg=__uint_as_float(rr[0])+__uint_as_float(rr[1]);}
  if(hi2==0)wsf[32+r32b]=l_reg;asm volatile("s_waitcnt lgkmcnt(0)":::"memory");
  float rli[16];
  #pragma unroll
  for(int r=0;r<16;++r)rli[r]=__builtin_amdgcn_rcpf(wsf[32+crow(r,hi2)]);
  bf16*Ow=O+(rowbase+q0+wid*QBLK)*DM+h*D;
  { bf16*stg=(bf16*)(shm+LDS_OST)+wid*2048;
    #pragma unroll
    for(int r=0;r<16;++r){const int orow=crow(r,hi2);
      #pragma unroll
      for(int d0=0;d0<2;++d0)stg[orow*64+d0*32+r32b]=__float2bfloat16(o[d0][r]*rli[r]);}
    asm volatile("s_waitcnt lgkmcnt(0)":::"memory");
    #pragma unroll
    for(int i=0;i<4;++i){const int row=i*8+(lane>>3),ch=lane&7; const u32x4 v=*(const u32x4*)(stg+row*64+ch*8); ATTN_STORE16(Ow+(long)row*DM+ch*8,v);} }
  asm volatile("s_waitcnt lgkmcnt(0)\n\ts_barrier":::"memory");
  #undef KT
  #undef DMA_K
  #undef DMA_V
  #undef CMASK
  #undef START
  #undef RESC
  #undef ROT
}
constexpr int ATTN_LDS_BYTES=LDS_BYTES;
struct AttnTensors { const bf16* Q; const bf16* K; const bf16* V; bf16* O; const float* ksum; };
struct AttnUnit { int bh; int qb; };
struct MobaOrder {
  int vcu;
  __device__ __forceinline__ bool next(int i,AttnUnit&u)const{ if(i>=4)return false; const int s=vcu&1; u.bh=vcu>>1;
    u.qb=(s==0)?((i==0)?7:(i==1)?0:(i==2)?5:2):((i==0)?6:(i==1)?1:(i==2)?4:3); return true; }
};
template<class Sched,int THRL=8> __device__ __forceinline__ void attn_phase(char*lds,const AttnTensors&T,const Sched&S,const int tid){
  AttnUnit u;
  for(int i=0;S.next(i,u);++i){ attn_unit<THRL>(u.bh/NHEAD,u.bh%NHEAD,u.qb,T.Q,T.K,T.V,T.O,T.ksum,lds,tid); }
}
#undef SBAR
#undef WAIT_BAR
}
#define GAS __attribute__((address_space(1)))
#define LAS __attribute__((address_space(3)))
typedef unsigned short bf16;
typedef unsigned v4u __attribute__((ext_vector_type(4)));
typedef float f32x4 __attribute__((ext_vector_type(4)));
typedef short bf16x8 __attribute__((ext_vector_type(8)));
typedef GAS unsigned gu32;
typedef GAS unsigned long long gu64;
#define RLX_AGENT __ATOMIC_RELAXED, __HIP_MEMORY_SCOPE_AGENT
#define LDS_WAIT() asm volatile("s_waitcnt lgkmcnt(0)" ::: "memory")
#define VM_WAIT() asm volatile("s_waitcnt vmcnt(0)" ::: "memory")
__device__ __forceinline__ unsigned long long rt() { return __builtin_amdgcn_s_memrealtime(); }
__device__ __forceinline__ unsigned f2bf(float f) { unsigned u = __builtin_bit_cast(unsigned, f); return (u + 0x7fffu + ((u >> 16) & 1u)) >> 16; }
__device__ __forceinline__ unsigned pk2(float lo, float hi) { return f2bf(lo) | (f2bf(hi) << 16); }

#define XB_TMO      128
#define XB_XCNT(j)  (256  + 64 * (j))
#define XB_XSUB(j)  (1280 + 64 * (j))
#define XB_XGEN(j)  (2304 + 64 * (j))
#define XB_TOP      3328
#define XB_TOPGEN   3392
#define XCD_BAR_WORDS 3456
#define XB_SPIN_CAP (1u << 18)

__device__ __forceinline__ unsigned xb_ld(unsigned* p)              { return __hip_atomic_load(p, __ATOMIC_RELAXED, __HIP_MEMORY_SCOPE_AGENT); }
__device__ __forceinline__ unsigned xb_add(unsigned* p, unsigned v) { return __hip_atomic_fetch_add(p, v, __ATOMIC_RELAXED, __HIP_MEMORY_SCOPE_AGENT); }
__device__ __forceinline__ unsigned xb_xcc_id() { return (unsigned)__builtin_amdgcn_s_getreg((3 << 11) | 20) & 0xFu; }
#define XB_SPIN(cond, bar) do { unsigned _sp = 0; while (cond) { __builtin_amdgcn_s_sleep(1); \
    if ((++_sp & 255u) == 0u) { if (xb_ld(&(bar)[XB_TMO])) break; if (_sp > XB_SPIN_CAP) { atomicAdd(&(bar)[XB_TMO], 1u); break; } } } } while (0)

struct XcdBarrier {
    unsigned* bar; unsigned x;
    volatile LAS unsigned* st;
};

__device__ __forceinline__ XcdBarrier xcd_barrier_post(unsigned* bar, volatile LAS unsigned* st) {
    XcdBarrier b; b.bar = bar; b.x = xb_xcc_id(); b.st = st;
    if (threadIdx.x == 0) (void)xb_add(&bar[XB_XCNT(b.x)], 1u);
    return b;
}
__device__ __forceinline__ void xcd_barrier_complete(unsigned* bar, unsigned x, unsigned& nloc, unsigned& nx) {
    const unsigned G = gridDim.x * gridDim.y * gridDim.z;
    unsigned sum, cnt, mine, sp = 0u;
    for (;;) {
        sum = 0u; cnt = 0u; mine = 0u;
#pragma unroll
        for (unsigned j = 0; j < 16; ++j) { const unsigned c = xb_ld(&bar[XB_XCNT(j)]); sum += c; cnt += (c > 0u) ? 1u : 0u; mine = (j == x) ? c : mine; }
        if (sum == G) break;
        __builtin_amdgcn_s_sleep(1);
        if ((++sp & 255u) == 0u) { if (xb_ld(&bar[XB_TMO])) break; if (sp > XB_SPIN_CAP) { atomicAdd(&bar[XB_TMO], 1u); break; } }
    }
    nloc = mine > 0u ? mine : 1u; nx = cnt > 0u ? cnt : 1u;
}

__device__ __forceinline__ void xcd_barrier(const XcdBarrier& b) {
    asm volatile("s_waitcnt vmcnt(0)" ::: "memory");
    __syncthreads();
    if (threadIdx.x == 0) {
        unsigned* bar = b.bar;
        __builtin_amdgcn_s_waitcnt(0);
        unsigned nloc = b.st[0], nx = b.st[1];
        if (nloc == 0u) { xcd_barrier_complete(bar, b.x, nloc, nx); b.st[0] = nloc; b.st[1] = nx; }
        const unsigned old = xb_add(&bar[XB_XSUB(b.x)], 1u);
        const unsigned gen = old / nloc;
        if (old + 1u == (gen + 1u) * nloc) {
            __builtin_amdgcn_fence(__ATOMIC_RELEASE, "agent");
            asm volatile("s_waitcnt vmcnt(0)" ::: "memory");
            const unsigned og = xb_add(&bar[XB_TOP], 1u);
            const unsigned tg = og / nx;
            if (og + 1u == (tg + 1u) * nx) xb_add(&bar[XB_TOPGEN], 1u);
            else XB_SPIN(xb_ld(&bar[XB_TOPGEN]) == tg, bar);
            __builtin_amdgcn_fence(__ATOMIC_ACQUIRE, "agent");
            xb_add(&bar[XB_XGEN(b.x)], 1u);
            asm volatile("s_waitcnt vmcnt(0)" ::: "memory");
        } else {
            XB_SPIN(xb_ld(&bar[XB_XGEN(b.x)]) == gen, bar);
            __builtin_amdgcn_fence(__ATOMIC_ACQUIRE, "agent");
            asm volatile("s_waitcnt vmcnt(0)" ::: "memory");
        }
    }
    __syncthreads();
}
constexpr int NWAVES = 8;
constexpr int BATCH = 8, SEQ = 2048, D = 1024, NH = 16, HD = 64, DEPTH = 4;
constexpr int M = BATCH * SEQ;
constexpr int NQKV = 3 * D, DV = 3072, NZ = 2 * DV, GG = 8, GD = 384, CHK = 128;
constexpr int NE = 64, EPG = 8, FE = 256, NRT = 80;
constexpr float LN_EPS = 1e-5f, ALPHA = 1.681792830507429f;
constexpr float QSCALE = 0.125f * 1.4426950408889634f;
constexpr int TOKCAP = 16384;
constexpr int MAXTILES = 192;

constexpr size_t MiB = 1u << 20;
constexpr size_t WS_CTL = 0, CTL_ZERO_BYTES = 1 * MiB;
constexpr size_t WS_WQKV = 2 * MiB;
constexpr size_t WS_WO = 14 * MiB;
constexpr size_t WS_WIN = 18 * MiB;
constexpr size_t WS_WOUT = 42 * MiB;
constexpr size_t WS_WR = 54 * MiB;
constexpr size_t WS_XB = 56 * MiB;
constexpr size_t WS_KSUM = 57 * MiB;
constexpr size_t WS_VPART = 58 * MiB;
constexpr size_t WS_TOK = 64 * MiB;
constexpr size_t WS_ASG = 68 * MiB;
constexpr size_t WS_XN = 72 * MiB;
constexpr size_t WS_QO = 104 * MiB, WS_K = 136 * MiB, WS_V = 168 * MiB;
constexpr size_t WS_U = 104 * MiB, WS_VV = 200 * MiB;
constexpr size_t WS_HB = 296 * MiB;
constexpr size_t WS_YB = 320 * MiB;
constexpr size_t WS_W13 = 416 * MiB;
constexpr size_t WS_W2 = 672 * MiB;
constexpr size_t WS_END = 800 * MiB;
constexpr int CW_TMO = 0, CW_CODE = 1;
constexpr int CW_BAR = 4096;
constexpr int CW_SEAM = 16384;
constexpr int CW_CNT = 32768;
constexpr int RING_OFF = 0, RING_BYTES = 131072;
constexpr int LDSCTL_OFF = RING_BYTES, MISC_OFF = LDSCTL_OFF + 320;
constexpr int TAB_OFF = LDSCTL_OFF + 1024;
constexpr int LDS_BYTES = 147456;

struct Args { const float* in[21]; float* out; unsigned char* ws; int ph_lo, ph_hi; };
struct Frame {
    LAS unsigned char* lds;
    volatile LAS unsigned* MISC;
    gu32* ctl;
    int tid, lane, wave;
    int vcu, G;
    float* out; unsigned char* ws;
    bf16 *XN, *QO, *KB, *VB, *UB, *VVB, *HB, *YB;
};
__device__ __forceinline__ float wave_sum(float v) {
#pragma unroll
    for (int o = 1; o < 64; o <<= 1) v += __shfl_xor(v, o);
    return v;
}
__device__ __forceinline__ float bflo(unsigned w) { return __uint_as_float(w << 16); }
__device__ __forceinline__ float bfhi(unsigned w) { return __uint_as_float(w & 0xffff0000u); }
template <class T> __device__ __forceinline__ T* opaque(T* p) { asm volatile("" : "+v"(p)); return p; }

__device__ __forceinline__ void p0_transpose_tile(const float* W, int N, int k0, int n0, bf16* WTrow, int ldt, LAS float* scr, int lane) {
#pragma unroll 4
    for (int i = 0; i < 32; ++i) { const int kk = 2 * i + (lane >> 5); scr[kk * 33 + (lane & 31)] = W[(size_t)(k0 + kk) * N + n0 + (lane & 31)]; }
    LDS_WAIT(); asm volatile("" ::: "memory");
    const int c = lane & 7;
#pragma unroll
    for (int j = 0; j < 4; ++j) { const int n = (lane >> 3) + 8 * j; const LAS float* s = scr + (8 * c) * 33 + n;
        v4u o; o.x = pk2(s[0 * 33], s[1 * 33]); o.y = pk2(s[2 * 33], s[3 * 33]); o.z = pk2(s[4 * 33], s[5 * 33]); o.w = pk2(s[6 * 33], s[7 * 33]);
        *(GAS v4u*)(WTrow + (size_t)n * ldt + k0 + 8 * c) = o; }
    LDS_WAIT(); asm volatile("" ::: "memory");
}
__device__ __forceinline__ void p0_prologue(Frame& F, const Args& A) {
    LAS float* scr = (LAS float*)(F.lds + RING_OFF + F.wave * 16384);
    const int gw = F.vcu * NWAVES + F.wave, NGW = F.G * NWAVES;
    unsigned char* ws = F.ws;
    constexpr int I_QKV = 16 * 96, I_WO = 16 * 32, I_WIN = 16 * 192, I_WOUT = 48 * 32, I_DENSE = 2 * (I_QKV + I_WO + I_WIN + I_WOUT);
    constexpr int I_E = 128, I_MOE = DEPTH * NE * 3 * I_E;
    for (int it = gw; it < I_DENSE + I_MOE; it += NGW) {
        int r = it;
        if (r < I_DENSE) {
            if (r < 2 * I_QKV) { const int j = r / I_QKV; r %= I_QKV; const int kb = r / 96, nb = r % 96;
                p0_transpose_tile(A.in[1] + (size_t)j * D * NQKV, NQKV, kb * 64, nb * 32, (bf16*)(ws + WS_WQKV) + (size_t)j * NQKV * D + (size_t)(nb * 32) * D, D, scr, F.lane); continue; } r -= 2 * I_QKV;
            if (r < 2 * I_WO) { const int j = r / I_WO; r %= I_WO; const int kb = r / 32, nb = r % 32;
                p0_transpose_tile(A.in[2] + (size_t)j * D * D, D, kb * 64, nb * 32, (bf16*)(ws + WS_WO) + (size_t)j * D * D + (size_t)(nb * 32) * D, D, scr, F.lane); continue; } r -= 2 * I_WO;
            if (r < 2 * I_WIN) { const int j = r / I_WIN; r %= I_WIN; const int kb = r / 192, nb = r % 192;
                p0_transpose_tile(A.in[3] + (size_t)j * D * NZ, NZ, kb * 64, nb * 32, (bf16*)(ws + WS_WIN) + (size_t)j * NZ * D + (size_t)(nb * 32) * D, D, scr, F.lane); continue; } r -= 2 * I_WIN;
            { const int j = r / I_WOUT; r %= I_WOUT; const int kb = r / 32, nb = r % 32;
                p0_transpose_tile(A.in[9] + (size_t)j * DV * D, D, kb * 64, nb * 32, (bf16*)(ws + WS_WOUT) + (size_t)j * D * DV + (size_t)(nb * 32) * DV, DV, scr, F.lane); continue; }
        }
        r -= I_DENSE;
        const int le = r / (3 * I_E); r %= 3 * I_E; const int which = r / I_E; r %= I_E;
        if (which < 2) {
            const int kb = r / 8, nb = r % 8, n0 = nb * 32;
            p0_transpose_tile(A.in[18 + which] + (size_t)le * D * FE, FE, kb * 64, n0, (bf16*)(ws + WS_W13) + (size_t)le * 512 * D + (size_t)((n0 >> 7) * 256 + which * 128 + (n0 & 127)) * D, D, scr, F.lane);
        } else {
            const int kb = r / 32, nb = r % 32;
            p0_transpose_tile(A.in[20] + (size_t)le * FE * D, D, kb * 64, nb * 32, (bf16*)(ws + WS_W2) + (size_t)le * D * FE + (size_t)(nb * 32) * FE, FE, scr, F.lane);
        }
    }
    const int gt = F.vcu * (NWAVES * 64) + F.tid, NGT = F.G * NWAVES * 64;
    for (int idx = gt; idx < DEPTH * NRT * D; idx += NGT) {
        const int l = idx / (NRT * D), n = (idx / D) % NRT, k = idx % D;
        float w = 0.f; if (n < 8) w = A.in[14][((size_t)l * D + k) * 8 + n]; else if (n < 72) w = A.in[16][((size_t)l * D + k) * NE + (n - 8)];
        const unsigned hi = f2bf(w); const float lo = w - __uint_as_float(hi << 16);
        bf16* wr = (bf16*)(ws + WS_WR) + (size_t)l * 2 * NRT * D + (size_t)n * D + k;
        wr[0] = (bf16)hi; wr[(size_t)NRT * D] = (bf16)f2bf(lo);
    }
    for (int idx = gt; idx < M * D / 8; idx += NGT) {
        const f32x4 a = ((const f32x4*)A.in[0])[2 * idx], b = ((const f32x4*)A.in[0])[2 * idx + 1];
        v4u o; o.x = pk2(a[0], a[1]); o.y = pk2(a[2], a[3]); o.z = pk2(b[0], b[1]); o.w = pk2(b[2], b[3]);
        ((GAS v4u*)F.XN)[idx] = o;
    }
}

__device__ __forceinline__ void attn_naive_phase(Frame& F, bf16* Oout) {
    const int gw = F.vcu * NWAVES + F.wave, NGW = F.G * NWAVES;
    const float* ks = (const float*)(F.ws + WS_KSUM);
    for (int wu = gw; wu < BATCH * NH * (SEQ / 64); wu += NGW) {
        const int bh = wu / (SEQ / 64), qc = wu % (SEQ / 64), b = bh / NH, h = bh % NH;
        const int q = qc * 64 + F.lane, qb = (qc * 64) >> 8;
        const size_t rowq = (size_t)b * SEQ + q;
        unsigned qp[32];
        { const v4u* qg = (const v4u*)(F.QO + rowq * D + h * HD);
#pragma unroll
          for (int c = 0; c < 8; ++c) { const v4u w = qg[c]; qp[4 * c + 0] = w.x; qp[4 * c + 1] = w.y; qp[4 * c + 2] = w.z; qp[4 * c + 3] = w.w; } }
        unsigned sel = (1u << qb) - 1u;
        if (qb > 3) {
            float t0 = -INFINITY, t1 = -INFINITY, t2 = -INFINITY; int i0 = 0, i1 = 0, i2 = 0;
#pragma unroll 1
            for (int j = 0; j < qb; ++j) {
                const f32x4* k0 = opaque((const f32x4*)(ks + ((size_t)(b * 8 + j)) * 1024 + h * HD)); const f32x4* k1 = k0 + (size_t)64 * 256; float s = 0.f;
#pragma unroll
                for (int c = 0; c < 8; ++c) { const f32x4 a0 = k0[2 * c] + k1[2 * c], a1 = k0[2 * c + 1] + k1[2 * c + 1];
                    s += bflo(qp[4 * c + 0]) * a0[0] + bfhi(qp[4 * c + 0]) * a0[1] + bflo(qp[4 * c + 1]) * a0[2] + bfhi(qp[4 * c + 1]) * a0[3]
                       + bflo(qp[4 * c + 2]) * a1[0] + bfhi(qp[4 * c + 2]) * a1[1] + bflo(qp[4 * c + 3]) * a1[2] + bfhi(qp[4 * c + 3]) * a1[3]; }
                asm volatile("" : "+v"(s));
                if (s > t0) { t2 = t1; i2 = i1; t1 = t0; i1 = i0; t0 = s; i0 = j; } else if (s > t1) { t2 = t1; i2 = i1; t1 = s; i1 = j; } else if (s > t2) { t2 = s; i2 = j; }
            }
            sel = (1u << i0) | (1u << i1) | (1u << i2);
        }
        float mx = -INFINITY, l = 0.f, o[64];
#pragma unroll
        for (int d = 0; d < 64; ++d) o[d] = 0.f;
        for (int j = 0; j <= qb; ++j) {
            const bool use = (j == qb) || ((sel >> j) & 1u);
            const int kend = (j == qb) ? (qc * 64 + 64 - qb * 256) : 256;
#pragma unroll 1
            for (int kk = 0; kk < kend; ++kk) {
                const int key = j * 256 + kk;
                const v4u* kp = opaque((const v4u*)(F.KB + ((size_t)b * SEQ + key) * D + h * HD));
                float s = 0.f;
#pragma unroll
                for (int c = 0; c < 8; ++c) { const v4u w = kp[c]; s += bflo(qp[4 * c + 0]) * bflo(w.x) + bfhi(qp[4 * c + 0]) * bfhi(w.x) + bflo(qp[4 * c + 1]) * bflo(w.y) + bfhi(qp[4 * c + 1]) * bfhi(w.y)
                    + bflo(qp[4 * c + 2]) * bflo(w.z) + bfhi(qp[4 * c + 2]) * bfhi(w.z) + bflo(qp[4 * c + 3]) * bflo(w.w) + bfhi(qp[4 * c + 3]) * bfhi(w.w); }
                asm volatile("" : "+v"(s));
                const bool ok = use && (key <= q);
                const float mn = ok ? fmaxf(mx, s) : mx;
                const float a = (mn == mx) ? 1.0f : __builtin_amdgcn_exp2f(mx - mn);
                const float p = ok ? __builtin_amdgcn_exp2f(s - mn) : 0.f;
                l = l * a + p; mx = mn;
                const v4u* vp = opaque((const v4u*)(F.VB + ((size_t)b * SEQ + key) * D + h * HD));
#pragma unroll
                for (int c = 0; c < 8; ++c) { const v4u w = vp[c];
                    o[8 * c + 0] = o[8 * c + 0] * a + p * bflo(w.x); o[8 * c + 1] = o[8 * c + 1] * a + p * bfhi(w.x); o[8 * c + 2] = o[8 * c + 2] * a + p * bflo(w.y); o[8 * c + 3] = o[8 * c + 3] * a + p * bfhi(w.y);
                    o[8 * c + 4] = o[8 * c + 4] * a + p * bflo(w.z); o[8 * c + 5] = o[8 * c + 5] * a + p * bfhi(w.z); o[8 * c + 6] = o[8 * c + 6] * a + p * bflo(w.w); o[8 * c + 7] = o[8 * c + 7] * a + p * bfhi(w.w); }
            }
        }
        const float rl = 1.0f / l;
        GAS v4u* op = (GAS v4u*)(Oout + rowq * D + h * HD);
#pragma unroll
        for (int c = 0; c < 8; ++c) { v4u w; w.x = pk2(o[8 * c + 0] * rl, o[8 * c + 1] * rl); w.y = pk2(o[8 * c + 2] * rl, o[8 * c + 3] * rl); w.z = pk2(o[8 * c + 4] * rl, o[8 * c + 5] * rl); w.w = pk2(o[8 * c + 6] * rl, o[8 * c + 7] * rl); op[c] = w; }
    }
}

__device__ __forceinline__ void resln_phase(Frame& F, const bf16* Hout, const float* g, const float* bta) {
    const int gw = F.vcu * NWAVES + F.wave, NGW = F.G * NWAVES;
    for (int row = gw; row < M; row += NGW) {
        float v[16];
#pragma unroll
        for (int hf = 0; hf < 2; ++hf) { const v4u x = *(const v4u*)(F.XN + (size_t)row * D + hf * 512 + F.lane * 8), y = *(const v4u*)(Hout + (size_t)row * D + hf * 512 + F.lane * 8);
            v[8 * hf + 0] = ALPHA * bflo(x.x) + bflo(y.x); v[8 * hf + 1] = ALPHA * bfhi(x.x) + bfhi(y.x); v[8 * hf + 2] = ALPHA * bflo(x.y) + bflo(y.y); v[8 * hf + 3] = ALPHA * bfhi(x.y) + bfhi(y.y);
            v[8 * hf + 4] = ALPHA * bflo(x.z) + bflo(y.z); v[8 * hf + 5] = ALPHA * bfhi(x.z) + bfhi(y.z); v[8 * hf + 6] = ALPHA * bflo(x.w) + bflo(y.w); v[8 * hf + 7] = ALPHA * bfhi(x.w) + bfhi(y.w); }
        float s = 0.f;
#pragma unroll
        for (int i = 0; i < 16; ++i) s += v[i];
        const float mean = wave_sum(s) * (1.f / D); float s2 = 0.f;
#pragma unroll
        for (int i = 0; i < 16; ++i) { v[i] -= mean; s2 += v[i] * v[i]; }
        const float rstd = 1.f / sqrtf(wave_sum(s2) * (1.f / D) + LN_EPS);
#pragma unroll
        for (int hf = 0; hf < 2; ++hf) { const int c0 = hf * 512 + F.lane * 8; const f32x4 g0 = *(const f32x4*)(g + c0), g1 = *(const f32x4*)(g + c0 + 4), b0 = *(const f32x4*)(bta + c0), b1 = *(const f32x4*)(bta + c0 + 4);
            v4u o; o.x = pk2(v[8 * hf + 0] * rstd * g0[0] + b0[0], v[8 * hf + 1] * rstd * g0[1] + b0[1]); o.y = pk2(v[8 * hf + 2] * rstd * g0[2] + b0[2], v[8 * hf + 3] * rstd * g0[3] + b0[3]);
            o.z = pk2(v[8 * hf + 4] * rstd * g1[0] + b1[0], v[8 * hf + 5] * rstd * g1[1] + b1[1]); o.w = pk2(v[8 * hf + 6] * rstd * g1[2] + b1[2], v[8 * hf + 7] * rstd * g1[3] + b1[3]);
            *(GAS v4u*)(F.XN + (size_t)row * D + c0) = o; }
    }
}

__device__ __forceinline__ void router_phase(Frame& F, const Args& A, int l) {
    const int rg = F.wave & 3, kh = F.wave >> 2, fr = F.lane & 15, fq = F.lane >> 4;
    const bf16* Wr = (const bf16*)(F.ws + WS_WR) + (size_t)l * 2 * NRT * D;
    LAS float* part = (LAS float*)(F.lds + RING_OFF);
    int* tok = (int*)(F.ws + WS_TOK); int* asg = (int*)(F.ws + WS_ASG); float* gate = (float*)(F.ws + WS_ASG + 128 * 1024);
    for (int rb = F.vcu; rb < M / 64; rb += F.G) {
        const int row0 = rb * 64;
        const bf16* ap = F.XN + (size_t)(row0 + rg * 16 + fr) * D + kh * 512 + fq * 8;
        const bf16* bp = Wr + (size_t)fr * D + kh * 512 + fq * 8;
        f32x4 acc[5];
#pragma unroll
        for (int nf = 0; nf < 5; ++nf) acc[nf] = (f32x4){0.f, 0.f, 0.f, 0.f};
#pragma unroll 1
        for (int ks = 0; ks < 16; ++ks) {
            const bf16x8 a = *(const bf16x8*)(ap + ks * 32);
#pragma unroll
            for (int nf = 0; nf < 5; ++nf) {
                const bf16x8 bh = *(const bf16x8*)(bp + (size_t)nf * 16 * D + ks * 32), bl = *(const bf16x8*)(bp + (size_t)(NRT + nf * 16) * D + ks * 32);
                acc[nf] = __builtin_amdgcn_mfma_f32_16x16x32_bf16(a, bh, acc[nf], 0, 0, 0);
                acc[nf] = __builtin_amdgcn_mfma_f32_16x16x32_bf16(a, bl, acc[nf], 0, 0, 0);
            }
        }
#pragma unroll
        for (int nf = 0; nf < 5; ++nf)
#pragma unroll
            for (int j = 0; j < 4; ++j) part[(kh * 64 + rg * 16 + fq * 4 + j) * NRT + nf * 16 + fr] = acc[nf][j];
        __syncthreads();
        if (F.tid < 64) {
            const int t = F.tid, token = row0 + t;
            const LAS float* p0 = part + t * NRT; const LAS float* p1 = part + (64 + t) * NRT;
            float gl[8]; float gmax = -INFINITY; int gi = 0;
#pragma unroll
            for (int j = 0; j < 8; ++j) { gl[j] = p0[j] + p1[j] + A.in[15][l * 8 + j]; if (gl[j] > gmax) { gmax = gl[j]; gi = j; } }
            float gs = 0.f;
#pragma unroll
            for (int j = 0; j < 8; ++j) gs += __expf(gl[j] - gmax);
            const float gp = 1.0f / gs;
            float v0 = -INFINITY, v1 = -INFINITY; int i0 = 0, i1 = 0;
#pragma unroll
            for (int j = 0; j < 8; ++j) { const float e = p0[8 + gi * 8 + j] + p1[8 + gi * 8 + j] + A.in[17][l * NE + gi * 8 + j];
                if (e > v0) { v1 = v0; i1 = i0; v0 = e; i0 = j; } else if (e > v1) { v1 = e; i1 = j; } }
            const float pa = 1.0f / (1.0f + __expf(v1 - v0)), pb = 1.0f - pa;
            const int e0 = gi * 8 + i0, e1 = gi * 8 + i1;
            const unsigned q0 = __hip_atomic_fetch_add((unsigned*)(F.ctl + CW_CNT + l * NE + e0), 1u, RLX_AGENT);
            const unsigned q1 = __hip_atomic_fetch_add((unsigned*)(F.ctl + CW_CNT + l * NE + e1), 1u, RLX_AGENT);
            tok[e0 * TOKCAP + q0] = token; tok[e1 * TOKCAP + q1] = token;
            asg[token * 2 + 0] = (e0 << 16) | (int)q0; asg[token * 2 + 1] = (e1 << 16) | (int)q1;
            gate[token * 2 + 0] = gp * pa; gate[token * 2 + 1] = gp * pb;
        }
        __syncthreads();
    }
}

__device__ __forceinline__ int moe_tables(Frame& F, int l) {
    LAS int* cnt = (LAS int*)(F.lds + TAB_OFF); LAS int* tstart = cnt + 64; LAS int* tile_e = cnt + 64 + 68;
    if (F.tid < 64) cnt[F.tid] = (int)__hip_atomic_load(F.ctl + CW_CNT + l * NE + F.tid, RLX_AGENT);
    __syncthreads();
    if (F.tid == 0) { int s = 0; for (int e = 0; e < NE; ++e) { tstart[e] = s; s += (cnt[e] + 255) >> 8; } tstart[NE] = s; }
    __syncthreads();
    const int ntiles = tstart[NE];
    if (F.tid < ntiles && F.tid < 256) { int e = 0; for (int k = 0; k < NE; ++k) if (tstart[k + 1] <= F.tid) e = k + 1; tile_e[F.tid] = e; }
    __syncthreads();
    return ntiles < MAXTILES ? ntiles : MAXTILES;
}
struct MoeOrder {
    int ntiles, npn, G, c; const LAS int* cnt; const LAS int* tstart; const LAS int* tile_e;
    __device__ __forceinline__ bool next(int i, pg8::Unit& u) const {
        const int L = i * G + c; if (L >= ntiles * npn) return false;
        const int tile = L / npn, pn = L % npn, e = tile_e[tile], chunk = tile - tstart[e];
        u.pm = tile; u.pn = pn; u.pb = e * npn + pn; u.gofs = e * TOKCAP + chunk * 256; const int left = cnt[e] - chunk * 256; u.gcnt = left < 256 ? left : 256; return true;
    }
};

__device__ __forceinline__ void combine_phase(Frame& F, int l, const float* g, const float* bta, bool last_layer) {
    const LAS int* tstart = (const LAS int*)(F.lds + TAB_OFF) + 64;
    const int gw = F.vcu * NWAVES + F.wave, NGW = F.G * NWAVES;
    const int* asg = (const int*)(F.ws + WS_ASG); const float* gate = (const float*)(F.ws + WS_ASG + 128 * 1024);
    for (int row = gw; row < M; row += NGW) {
        const int* ap = opaque(asg + row * 2); const float* gp = opaque(gate + row * 2);
        const int a0 = ap[0], a1 = ap[1]; const float g0 = gp[0], g1 = gp[1];
        const size_t r0 = (size_t)tstart[a0 >> 16] * 256 + (a0 & 0xffff), r1 = (size_t)tstart[a1 >> 16] * 256 + (a1 & 0xffff);
        float v[16];
#pragma unroll
        for (int hf = 0; hf < 2; ++hf) { const int c0 = hf * 512 + F.lane * 8;
            const v4u x = *(const v4u*)(F.XN + (size_t)row * D + c0), y = *(const v4u*)(F.YB + r0 * D + c0), z = *(const v4u*)(F.YB + r1 * D + c0);
            v[8 * hf + 0] = ALPHA * bflo(x.x) + g0 * bflo(y.x) + g1 * bflo(z.x); v[8 * hf + 1] = ALPHA * bfhi(x.x) + g0 * bfhi(y.x) + g1 * bfhi(z.x);
            v[8 * hf + 2] = ALPHA * bflo(x.y) + g0 * bflo(y.y) + g1 * bflo(z.y); v[8 * hf + 3] = ALPHA * bfhi(x.y) + g0 * bfhi(y.y) + g1 * bfhi(z.y);
            v[8 * hf + 4] = ALPHA * bflo(x.z) + g0 * bflo(y.z) + g1 * bflo(z.z); v[8 * hf + 5] = ALPHA * bfhi(x.z) + g0 * bfhi(y.z) + g1 * bfhi(z.z);
            v[8 * hf + 6] = ALPHA * bflo(x.w) + g0 * bflo(y.w) + g1 * bflo(z.w); v[8 * hf + 7] = ALPHA * bfhi(x.w) + g0 * bfhi(y.w) + g1 * bfhi(z.w); }
        float s = 0.f;
#pragma unroll
        for (int i = 0; i < 16; ++i) s += v[i];
        const float mean = wave_sum(s) * (1.f / D); float s2 = 0.f;
#pragma unroll
        for (int i = 0; i < 16; ++i) { v[i] -= mean; s2 += v[i] * v[i]; }
        const float rstd = 1.f / sqrtf(wave_sum(s2) * (1.f / D) + LN_EPS);
#pragma unroll
        for (int hf = 0; hf < 2; ++hf) { const int c0 = hf * 512 + F.lane * 8; const f32x4 g0v = *(const f32x4*)(g + c0), g1v = *(const f32x4*)(g + c0 + 4), b0 = *(const f32x4*)(bta + c0), b1 = *(const f32x4*)(bta + c0 + 4);
            float o[8];
#pragma unroll
            for (int i = 0; i < 4; ++i) { o[i] = v[8 * hf + i] * rstd * g0v[i] + b0[i]; o[4 + i] = v[8 * hf + 4 + i] * rstd * g1v[i] + b1[i]; }
            if (last_layer) { GAS f32x4* op = (GAS f32x4*)(F.out + (size_t)row * D + c0); op[0] = (f32x4){o[0], o[1], o[2], o[3]}; op[1] = (f32x4){o[4], o[5], o[6], o[7]}; }
            else { v4u w; w.x = pk2(o[0], o[1]); w.y = pk2(o[2], o[3]); w.z = pk2(o[4], o[5]); w.w = pk2(o[6], o[7]); *(GAS v4u*)(F.XN + (size_t)row * D + c0) = w; } }
    }
}

__device__ __forceinline__ void g2a_phase(Frame& F) {
    typedef float f32x2v __attribute__((ext_vector_type(2)));
    const int gt = F.vcu * (NWAVES * 64) + F.tid, NGT = F.G * NWAVES * 64;
    const f32x2v* vp = (const f32x2v*)(F.ws + WS_VPART); f32x2v* vs = (f32x2v*)(F.ws + WS_ASG + 256 * 1024);
    for (int row = gt; row < M; row += NGT) { float s1 = 0.f, s2 = 0.f;
        for (int i = 0; i < 48; ++i) { const f32x2v p = vp[(size_t)row * 48 + i]; s1 += p.x; s2 += p.y; }
        const float mean = s1 * (1.f / DV), var = s2 * (1.f / DV) - mean * mean;
        vs[row] = (f32x2v){mean, 1.f / sqrtf(fmaxf(var, 0.f) + LN_EPS)}; }
}
__device__ __forceinline__ void g2b_naive_phase(Frame& F, const Args& A, int j) {
    typedef float f32x2v __attribute__((ext_vector_type(2)));
    const int gt = F.vcu * (NWAVES * 64) + F.tid, NGT = F.G * NWAVES * 64;
    const f32x2v* vs = (const f32x2v*)(F.ws + WS_ASG + 256 * 1024);
    const float* lg = A.in[5] + (size_t)j * DV; const float* lb = A.in[6] + (size_t)j * DV;
    const float* Ws = A.in[7] + (size_t)j * GG * CHK * CHK; const float* bs = A.in[8] + (size_t)j * GG * CHK;
    for (int id = gt; id < M * (DV / 8); id += NGT) {
        const int row = id / (DV / 8), k0 = (id % (DV / 8)) * 8, g = k0 / GD, t = row & (CHK - 1), r0 = row - t;
        float gk[8], bk[8], acc[8];
#pragma unroll
        for (int i = 0; i < 8; ++i) { gk[i] = lg[k0 + i]; bk[i] = lb[k0 + i]; acc[i] = 0.f; }
        const float* wrow = Ws + ((size_t)g * CHK + t) * CHK;
        for (int s = 0; s <= t; ++s) {
            const float w = wrow[s]; const f32x2v st = vs[r0 + s];
            const v4u vv = *(const v4u*)(F.VVB + (size_t)(r0 + s) * DV + k0);
            const float ws_ = w * st.y;
            acc[0] += ws_ * (bflo(vv.x) - st.x) * gk[0] + w * bk[0]; acc[1] += ws_ * (bfhi(vv.x) - st.x) * gk[1] + w * bk[1];
            acc[2] += ws_ * (bflo(vv.y) - st.x) * gk[2] + w * bk[2]; acc[3] += ws_ * (bfhi(vv.y) - st.x) * gk[3] + w * bk[3];
            acc[4] += ws_ * (bflo(vv.z) - st.x) * gk[4] + w * bk[4]; acc[5] += ws_ * (bfhi(vv.z) - st.x) * gk[5] + w * bk[5];
            acc[6] += ws_ * (bflo(vv.w) - st.x) * gk[6] + w * bk[6]; acc[7] += ws_ * (bfhi(vv.w) - st.x) * gk[7] + w * bk[7];
        }
        const float bt = bs[g * CHK + t];
        const v4u uu = *(const v4u*)(F.UB + (size_t)row * DV + k0);
        v4u o; o.x = pk2(bflo(uu.x) * (acc[0] + bt), bfhi(uu.x) * (acc[1] + bt)); o.y = pk2(bflo(uu.y) * (acc[2] + bt), bfhi(uu.y) * (acc[3] + bt));
        o.z = pk2(bflo(uu.z) * (acc[4] + bt), bfhi(uu.z) * (acc[5] + bt)); o.w = pk2(bflo(uu.w) * (acc[6] + bt), bfhi(uu.w) * (acc[7] + bt));
        *(GAS v4u*)(F.UB + (size_t)row * DV + k0) = o;
    }
}


typedef short v4i16_t __attribute__((ext_vector_type(4)));
__device__ __forceinline__ void g2_mfma_phase(Frame& F, const Args& A, int j) {
    typedef float f32x2v __attribute__((ext_vector_type(2)));
    constexpr int WB_OFF = 0, WPITCH = 272, ST_OFF = 34816, VL_OFF = 36864, VPITCH = 416;
    const int tid = F.tid, lane = F.lane, wid = F.wave, th = wid & 1, cq = wid >> 1, fr = lane & 15, fq = lane >> 4;
    LAS unsigned char* L = F.lds + RING_OFF;
    const int g = F.vcu & 7;
    const float* lg = A.in[5] + (size_t)j * DV + g * GD; const float* lb = A.in[6] + (size_t)j * DV + g * GD;
    const float* Ws = A.in[7] + ((size_t)j * GG + g) * CHK * CHK; const float* bs = A.in[8] + ((size_t)j * GG + g) * CHK;
    const f32x2v* vpart = (const f32x2v*)(F.ws + WS_VPART);
#pragma unroll
    for (int i = 0; i < 8; ++i) { const int p = tid + 512 * i, t = p >> 5, s0 = (p & 31) * 4; const f32x4 w = *(const f32x4*)(Ws + t * CHK + s0);
        const unsigned lo = pk2(s0 + 0 <= t ? w[0] : 0.f, s0 + 1 <= t ? w[1] : 0.f), hi = pk2(s0 + 2 <= t ? w[2] : 0.f, s0 + 3 <= t ? w[3] : 0.f);
        *(LAS unsigned long long*)(L + WB_OFF + t * WPITCH + s0 * 2) = (unsigned long long)lo | ((unsigned long long)hi << 32); }
    float bst[4];
#pragma unroll
    for (int tf = 0; tf < 4; ++tf) bst[tf] = bs[64 * th + 16 * tf + fr];
    for (int uid = F.vcu; uid < (M / CHK) * GG; uid += F.G) {
        const int c = uid >> 3, row0 = c * CHK;
        { const int row = tid >> 2, q = tid & 3; const f32x2v* pp = vpart + (size_t)(row0 + row) * 48 + q * 12; float s1 = 0.f, s2 = 0.f;
#pragma unroll
          for (int i = 0; i < 12; ++i) { const f32x2v p = pp[i]; s1 += p.x; s2 += p.y; }
          s1 += __shfl_xor(s1, 1); s2 += __shfl_xor(s2, 1); s1 += __shfl_xor(s1, 2); s2 += __shfl_xor(s2, 2);
          const float mean = s1 * (1.f / DV), var = s2 * (1.f / DV) - mean * mean;
          if (q == 0) *(LAS f32x2v*)(L + ST_OFF + row * 8) = (f32x2v){mean, 1.f / sqrtf(fmaxf(var, 0.f) + LN_EPS)}; }
        __syncthreads();
        for (int half = 0; half < 2; ++half) {
            const int chb = g * GD + half * 192;
#pragma unroll
            for (int i = 0; i < 6; ++i) { const int p = tid + 512 * i, row = p / 24, ck = p % 24;
                const v4u vv = *(const v4u*)(F.VVB + (size_t)(row0 + row) * DV + chb + ck * 8);
                const f32x4 g0 = *(const f32x4*)(lg + half * 192 + ck * 8), g1 = *(const f32x4*)(lg + half * 192 + ck * 8 + 4), b0 = *(const f32x4*)(lb + half * 192 + ck * 8), b1 = *(const f32x4*)(lb + half * 192 + ck * 8 + 4);
                const f32x2v st = *(const LAS f32x2v*)(L + ST_OFF + row * 8);
                const f32x4 a0 = g0 * st.y, a1 = g1 * st.y, c0 = b0 - a0 * st.x, c1 = b1 - a1 * st.x;
                v4u o; o.x = pk2(bflo(vv.x) * a0[0] + c0[0], bfhi(vv.x) * a0[1] + c0[1]); o.y = pk2(bflo(vv.y) * a0[2] + c0[2], bfhi(vv.y) * a0[3] + c0[3]);
                o.z = pk2(bflo(vv.z) * a1[0] + c1[0], bfhi(vv.z) * a1[1] + c1[1]); o.w = pk2(bflo(vv.w) * a1[2] + c1[2], bfhi(vv.w) * a1[3] + c1[3]);
                *(LAS v4u*)(L + VL_OFF + row * VPITCH + ck * 16) = o; }
            __syncthreads();
            f32x4 acc[4][3];
#pragma unroll
            for (int tf = 0; tf < 4; ++tf)
#pragma unroll
                for (int cf = 0; cf < 3; ++cf) acc[tf][cf] = (f32x4){0.f, 0.f, 0.f, 0.f};
#pragma unroll
            for (int ks = 0; ks < 4; ++ks) {
                bf16x8 wf[4], vf[3];
#pragma unroll
                for (int tf = 0; tf < 4; ++tf) wf[tf] = *(const LAS bf16x8*)(L + WB_OFF + (64 * th + 16 * tf + fr) * WPITCH + (32 * ks + 8 * fq) * 2);
#pragma unroll
                for (int cf = 0; cf < 3; ++cf) { const int srow = 32 * ks + 8 * fq + (fr >> 2), cb = (48 * cq + 16 * cf + 4 * (fr & 3)) * 2;
                    const v4i16_t lo = __builtin_amdgcn_ds_read_tr16_b64_v4i16((LAS v4i16_t*)(L + VL_OFF + srow * VPITCH + cb));
                    const v4i16_t hi = __builtin_amdgcn_ds_read_tr16_b64_v4i16((LAS v4i16_t*)(L + VL_OFF + (srow + 4) * VPITCH + cb));
                    vf[cf] = (bf16x8){lo[0], lo[1], lo[2], lo[3], hi[0], hi[1], hi[2], hi[3]}; }
#pragma unroll
                for (int tf = 0; tf < 4; ++tf)
#pragma unroll
                    for (int cf = 0; cf < 3; ++cf) acc[tf][cf] = __builtin_amdgcn_mfma_f32_16x16x32_bf16(vf[cf], wf[tf], acc[tf][cf], 0, 0, 0);
            }
#pragma unroll
            for (int tf = 0; tf < 4; ++tf) { bf16* up = F.UB + (size_t)(row0 + 64 * th + 16 * tf + fr) * DV + chb + 48 * cq + 4 * fq;
#pragma unroll
                for (int cf = 0; cf < 3; ++cf) { const unsigned long long uu = *(const unsigned long long*)(up + 16 * cf); const unsigned ul = (unsigned)uu, uh = (unsigned)(uu >> 32);
                    const f32x4 m = acc[tf][cf] + bst[tf];
                    const unsigned ol = pk2(bflo(ul) * m[0], bfhi(ul) * m[1]), oh = pk2(bflo(uh) * m[2], bfhi(uh) * m[3]);
                    *(GAS unsigned long long*)(up + 16 * cf) = (unsigned long long)ol | ((unsigned long long)oh << 32); } }
            __syncthreads();
        }
    }
}

constexpr int NPHASES = 1 + 4 * 8;
#ifndef MK_N_LAUNCHES
#define MK_N_LAUNCHES 1
#endif
#ifndef CHECK_LIMIT
#define CHECK_LIMIT 16777u
#endif
#ifndef PG8_SP2
#define PG8_SP2 false
#endif
#ifndef DBG_QKV
#define DBG_QKV(...) __VA_ARGS__
#endif
#ifndef DBG_G1
#define DBG_G1(...) __VA_ARGS__
#endif
#ifndef DBG_WO
#define DBG_WO(...) __VA_ARGS__
#endif
#ifndef DBG_M1
#define DBG_M1(...) __VA_ARGS__
#endif
#ifndef DBG_M2
#define DBG_M2(...) __VA_ARGS__
#endif
#ifndef DBG_ATTN
#define DBG_ATTN(x) x
#endif
#ifndef DBG_G2B
#define DBG_G2B(x) x
#endif
#ifndef DBG_RT
#define DBG_RT(x) x
#endif
#ifndef DBG_P0
#define DBG_P0(x) x
#endif
#define MKFRAME() \
        unsigned char* ws; \
        { unsigned long long w = (unsigned long long)args.ws; unsigned wl = (unsigned)w, wh = (unsigned)(w >> 32); \
          asm volatile("" : "+v"(wl), "+v"(wh)); \
          wl = __builtin_amdgcn_readfirstlane(wl); wh = __builtin_amdgcn_readfirstlane(wh); \
          ws = (unsigned char*)(((unsigned long long)wh << 32) | wl); } \
        int tid_; asm volatile("v_mbcnt_lo_u32_b32 %0, -1, 0\n\tv_mbcnt_hi_u32_b32 %0, -1, %0" : "=&v"(tid_)); tid_ += wave0_ * 64; \
        Frame F; \
        F.lds = (LAS unsigned char*)lds; \
        F.MISC = (volatile LAS unsigned*)(F.lds + MISC_OFF); \
        F.tid = tid_; F.lane = F.tid & 63; F.wave = __builtin_amdgcn_readfirstlane(F.tid >> 6); \
        F.G = gridDim.x; { const int bx = blockIdx.x; F.vcu = (F.G % 8 == 0) ? (bx % 8) * (F.G / 8) + bx / 8 : bx; } \
        F.ws = ws; F.out = args.out; \
        F.ctl = (gu32*)(ws + WS_CTL); \
        F.XN = (bf16*)(ws + WS_XN); F.QO = (bf16*)(ws + WS_QO); F.KB = (bf16*)(ws + WS_K); F.VB = (bf16*)(ws + WS_V); F.UB = (bf16*)(ws + WS_U); F.VVB = (bf16*)(ws + WS_VV); \
        F.HB = (bf16*)(ws + WS_HB); F.YB = (bf16*)(ws + WS_YB);
__global__ void __launch_bounds__(NWAVES * 64, 2) fwd_kernel(Args args) {
    extern __shared__ __attribute__((aligned(16))) unsigned char lds[];
    for (int u = threadIdx.x; u < (LDS_BYTES - LDSCTL_OFF) / 4; u += NWAVES * 64) ((LAS unsigned*)((LAS unsigned char*)lds + LDSCTL_OFF))[u] = 0u;
    __syncthreads();
    const int lo = args.ph_lo, hi = args.ph_hi;
    const int wave0_ = __builtin_amdgcn_readfirstlane(threadIdx.x >> 6);
    XcdBarrier bar; bar.bar = (unsigned*)(args.ws + WS_CTL) + CW_BAR; bar.x = 0; bar.st = nullptr;
    if (hi - lo > 1) bar = xcd_barrier_post((unsigned*)(args.ws + WS_CTL) + CW_BAR, (volatile LAS unsigned*)((LAS unsigned char*)lds + MISC_OFF) + 8);
    for (int pk = lo; pk < hi; ++pk) {
        int kind = 0, l = 0;
        if (pk > 0) { const int p = pk - 1, r = p & 7; l = p >> 3;
            if (r >= 2) kind = r + 4; else if ((l & 1) == 0) kind = r + 1; else kind = (r == 0) ? 3 : 5; }
        const int j = l >> 1;
        if (kind == 0) { MKFRAME(); DBG_P0(p0_prologue(F, args)); }
        else if (kind == 1) { MKFRAME(); pg8::Gemm g{F.XN, (const bf16*)(ws + WS_WQKV) + (size_t)j * NQKV * D, M, NQKV, D, nullptr}; pg8::StaticOrder S; S.init(M, NQKV, F.G, (int)blockIdx.x);
            pg8::EpiBf16<0, 1> E{F.QO, D, nullptr, D, (size_t)(WS_K - WS_QO) / 2, QSCALE, (float*)(ws + WS_KSUM)};
            DBG_QKV(pg8::gemm_phase<pg8::EpiBf16<0, 1>, pg8::StaticOrder, true, PG8_SP2, false>(F.lds + RING_OFF, g, S, E, F.tid)); }
#if defined(ATTN_NAIVE)
        else if (kind == 2) { MKFRAME(); DBG_ATTN(attn_naive_phase(F, F.QO)); }
#else
        else if (kind == 2) { MKFRAME(); const attn_body::AttnTensors AT{(const attn_body::bf16*)F.QO, (const attn_body::bf16*)F.KB, (const attn_body::bf16*)F.VB, (attn_body::bf16*)F.QO, (const float*)(ws + WS_KSUM)};
            const attn_body::MobaOrder S{F.vcu};
#if defined(ATTN_CHECK)
            attn_naive_phase(F, F.YB); xcd_barrier(bar);
#endif
            DBG_ATTN(attn_body::attn_phase<attn_body::MobaOrder>((char*)lds + RING_OFF, AT, S, F.tid));
#if defined(ATTN_CHECK)
            xcd_barrier(bar);
            { int t3; asm volatile("v_mbcnt_lo_u32_b32 %0, -1, 0\n\tv_mbcnt_hi_u32_b32 %0, -1, %0" : "=&v"(t3)); t3 += wave0_ * 64;
              unsigned bad = 0; const int gt = (int)blockIdx.x * (NWAVES * 64) + t3, NGT = (int)gridDim.x * NWAVES * 64;
              for (int idx = gt; idx < M * D / 8; idx += NGT) { const v4u a = ((const v4u*)(args.ws + WS_QO))[idx], b = ((const v4u*)(args.ws + WS_YB))[idx];
                  bad += (fabsf(bflo(a.x) - bflo(b.x)) > 0.05f) + (fabsf(bfhi(a.x) - bfhi(b.x)) > 0.05f) + (fabsf(bflo(a.y) - bflo(b.y)) > 0.05f) + (fabsf(bfhi(a.y) - bfhi(b.y)) > 0.05f)
                       + (fabsf(bflo(a.z) - bflo(b.z)) > 0.05f) + (fabsf(bfhi(a.z) - bfhi(b.z)) > 0.05f) + (fabsf(bflo(a.w) - bflo(b.w)) > 0.05f) + (fabsf(bfhi(a.w) - bfhi(b.w)) > 0.05f); }
              if (bad) atomicAdd((unsigned*)(args.ws + WS_CTL) + 8 + l, bad); }
#endif
        }
#endif
        else if (kind == 3) { MKFRAME(); pg8::Gemm g{F.XN, (const bf16*)(ws + WS_WIN) + (size_t)j * NZ * D, M, NZ, D, nullptr}; pg8::StaticOrder S; S.init(M, NZ, F.G, (int)blockIdx.x);
            pg8::EpiBf16<1, 2> E{F.UB, DV, args.in[4] + (size_t)j * NZ, DV, (size_t)(WS_VV - WS_U) / 2, 1.0f, (float*)(ws + WS_VPART)};
            DBG_G1(pg8::gemm_phase<pg8::EpiBf16<1, 2>, pg8::StaticOrder, true, PG8_SP2, false>(F.lds + RING_OFF, g, S, E, F.tid)); }
#if defined(G2_NAIVE)
        else if (kind == 5) { MKFRAME(); g2a_phase(F); xcd_barrier(bar); DBG_G2B(g2b_naive_phase(F, args, j)); }
#else
        else if (kind == 5) { MKFRAME(); DBG_G2B(g2_mfma_phase(F, args, j)); }
#endif
        else if (kind == 6) { MKFRAME(); pg8::Gemm g; if ((l & 1) == 0) g = pg8::Gemm{F.QO, (const bf16*)(ws + WS_WO) + (size_t)j * D * D, M, D, D, nullptr}; else g = pg8::Gemm{F.UB, (const bf16*)(ws + WS_WOUT) + (size_t)j * D * DV, M, D, DV, nullptr};
            pg8::StaticOrder S; S.init(M, D, F.G, (int)blockIdx.x);
            pg8::EpiBf16<0, 0> E{F.YB, D, nullptr, 0, 0, 1.0f, nullptr};
            DBG_WO(pg8::gemm_phase<pg8::EpiBf16<0, 0>, pg8::StaticOrder, true, PG8_SP2, false>(F.lds + RING_OFF, g, S, E, F.tid)); }
        else if (kind == 7) { MKFRAME(); resln_phase(F, F.YB, args.in[10] + (size_t)l * D, args.in[11] + (size_t)l * D); }
        else if (kind == 8) { MKFRAME(); DBG_RT(router_phase(F, args, l)); }
        else if (kind == 9) { MKFRAME(); const int ntiles = moe_tables(F, l); const LAS int* tb = (const LAS int*)(F.lds + TAB_OFF);
            pg8::Gemm g{F.XN, (const bf16*)(ws + WS_W13) + (size_t)l * NE * 512 * D, M, 512, D, (const int*)(ws + WS_TOK)};
            MoeOrder S{ntiles, 2, F.G, F.vcu, tb, tb + 64, tb + 64 + 68};
            pg8::EpiMoe1 E{F.HB};
            DBG_M1(pg8::gemm_phase<pg8::EpiMoe1, MoeOrder, true, PG8_SP2, true>(F.lds + RING_OFF, g, S, E, F.tid)); }
        else if (kind == 10) { MKFRAME(); const int ntiles = moe_tables(F, l); const LAS int* tb = (const LAS int*)(F.lds + TAB_OFF);
            pg8::Gemm g{F.HB, (const bf16*)(ws + WS_W2) + (size_t)l * NE * D * FE, MAXTILES * 256, D, FE, nullptr};
            MoeOrder S{ntiles, 4, F.G, F.vcu, tb, tb + 64, tb + 64 + 68};
            pg8::EpiBf16<0, 0> E{F.YB, D, nullptr, 0, 0, 1.0f, nullptr};
            DBG_M2(pg8::gemm_phase<pg8::EpiBf16<0, 0>, MoeOrder, true, PG8_SP2, false>(F.lds + RING_OFF, g, S, E, F.tid)); }
        else { MKFRAME(); (void)moe_tables(F, l); combine_phase(F, l, args.in[12] + (size_t)l * D, args.in[13] + (size_t)l * D, l == DEPTH - 1);
#if defined(ATTN_CHECK) || defined(G2_CHECK)
            if (l == DEPTH - 1) { xcd_barrier(bar); const unsigned c0 = __hip_atomic_load(F.ctl + 8, RLX_AGENT), c1 = __hip_atomic_load(F.ctl + 9, RLX_AGENT), c2 = __hip_atomic_load(F.ctl + 10, RLX_AGENT), c3 = __hip_atomic_load(F.ctl + 11, RLX_AGENT);
                if (c0 > CHECK_LIMIT || c1 > CHECK_LIMIT || c2 > CHECK_LIMIT || c3 > CHECK_LIMIT) { const int gt = F.vcu * (NWAVES * 64) + F.tid; if (gt < 1024) F.out[gt] = __builtin_nanf(""); } }
#endif
        }
        if (pk + 1 < hi) xcd_barrier(bar);
    }
}

extern "C" void kernel_launch(void* const* d_in, const int* in_sizes, int n_in, void* d_out, int out_size, void* d_ws, size_t ws_size, hipStream_t stream) {
    static int grid = 0;
    if (grid == 0) {
        if (n_in != 21 || in_sizes[0] != M * D || out_size != M * D || ws_size < WS_END) { fprintf(stderr, "kernel_launch: unexpected shapes (n_in %d, in0 %d, out %d, ws %zu); nothing launched\n", n_in, n_in > 0 ? in_sizes[0] : -1, out_size, ws_size); grid = -1; return; }
        int dev = 0, cus = 0, per_cu = 0;
        if (hipGetDevice(&dev) != hipSuccess || hipDeviceGetAttribute(&cus, hipDeviceAttributeMultiprocessorCount, dev) != hipSuccess) { fprintf(stderr, "kernel_launch: device query failed\n"); grid = -1; return; }
        if (hipFuncSetAttribute((const void*)fwd_kernel, hipFuncAttributeMaxDynamicSharedMemorySize, LDS_BYTES) != hipSuccess) { fprintf(stderr, "kernel_launch: hipFuncSetAttribute failed\n"); grid = -1; return; }
        if (hipOccupancyMaxActiveBlocksPerMultiprocessor(&per_cu, (const void*)fwd_kernel, NWAVES * 64, LDS_BYTES) != hipSuccess || per_cu < 1)
            fprintf(stderr, "kernel_launch: note: occupancy query reports %d workgroups per CU\n", per_cu);
        (void)hipGetLastError();
        grid = cus;
        if (grid != 256) fprintf(stderr, "kernel_launch: %d CUs; this build expects 256\n", grid);
    }
    if (grid < 0) return;
    if (hipMemsetAsync((char*)d_ws + WS_CTL, 0, CTL_ZERO_BYTES, stream) != hipSuccess) { fprintf(stderr, "kernel_launch: hipMemsetAsync failed\n"); return; }
    Args a{};
    for (int i = 0; i < 21; ++i) a.in[i] = (const float*)d_in[i];
    a.out = (float*)d_out; a.ws = (unsigned char*)d_ws;
    constexpr int NL = MK_N_LAUNCHES;
    for (int li = 0; li < NL; ++li) {
        if (NL == 1) { a.ph_lo = 0; a.ph_hi = NPHASES; } else { a.ph_lo = li; a.ph_hi = li + 1; }
        hipLaunchKernelGGL(fwd_kernel, dim3(grid), dim3(NWAVES * 64), LDS_BYTES, stream, a);
        const hipError_t le = hipPeekAtLastError();
        if (le != hipSuccess) { fprintf(stderr, "kernel_launch: launch %d failed: %s\n", li, hipGetErrorName(le)); break; }
    }
}
```
